# Optimizing an MI355X kernel written in HIP

```python
import jax, jax.numpy as jnp
from jax import lax
import numpy as np

D_MODEL = 1024
BATCH = 2
SEQ = 16384
DEPTH = 2

N_MEM = 256
EPS = 1e-6
NEG = -1e30

NSA_HEAD_DIM = 64
NSA_HEADS = (D_MODEL // 2) // NSA_HEAD_DIM
NSA_KV_GROUPS = 2
NSA_Q_WIDTH = NSA_HEADS * NSA_HEAD_DIM
NSA_KV_WIDTH = NSA_KV_GROUPS * NSA_HEAD_DIM
L_CMP = 32
D_CMP = 16
CMP_HIDDEN = 2 * NSA_HEAD_DIM
L_SLC = 64
N_SLC_SEL = 16
WINDOW = 512
Q_BLOCK = 128
FORCE_BONUS = 1.0e3
SGU_WIDTH = D_MODEL // 4
SGU_GROUPS = 4
SGU_CHUNK = 128
POOL_WIDTH = D_MODEL // 4
POOL_WINDOWS = (2, 4, 8, 16)
N_BRANCH = 3
IN_SPLITS = (NSA_Q_WIDTH, 6 * NSA_KV_WIDTH, 3 * NSA_HEADS, 2 * SGU_WIDTH, POOL_WIDTH, N_BRANCH * D_MODEL)
IN_WIDTH = NSA_Q_WIDTH + 6 * NSA_KV_WIDTH + 3 * NSA_HEADS + 2 * SGU_WIDTH + POOL_WIDTH + N_BRANCH * D_MODEL
XA_HEADS = 4
XA_HEAD_DIM = 128
XA_WIDTH = XA_HEADS * XA_HEAD_DIM
PEER_HEADS = 8
PEER_KEYS = 128
PEER_EXPERTS = PEER_KEYS * PEER_KEYS
PEER_QDIM = 128
PEER_TOPK = 16
PEER_BLOCK = 128

kernel_name = "hybrid_nsa_sgu_pool_peer_block"


def rms_norm(x, g):
    xf = x.astype(jnp.float32)
    y = xf * lax.rsqrt(jnp.mean(xf * xf, axis=-1, keepdims=True) + EPS)
    return (y * g).astype(x.dtype)


def layer_norm(x, g, b):
    xf = x.astype(jnp.float32)
    mu = jnp.mean(xf, axis=-1, keepdims=True)
    var = jnp.mean(jnp.square(xf - mu), axis=-1, keepdims=True)
    return ((xf - mu) * lax.rsqrt(var + EPS) * g + b).astype(x.dtype)


def masked_softmax(s, mask):
    s = jnp.where(mask, s.astype(jnp.float32), NEG)
    e = jnp.exp(s - jnp.max(s, axis=-1, keepdims=True)) * mask
    return e / jnp.maximum(jnp.sum(e, axis=-1, keepdims=True), 1e-30)


def nsa_attention(q, kv, gate_logits, q_norm, k_norm, cmp_pe, cmp_w1, cmp_w2):
    B, S, H, dk = q.shape
    G = NSA_KV_GROUPS
    R = H // G
    scale = dk ** -0.5
    q = rms_norm(q, q_norm)

    n_cmp = (S - L_CMP) // D_CMP + 1
    cmp_idx = np.arange(n_cmp)[:, None] * D_CMP + np.arange(L_CMP)[None, :]
    kv_raw = jnp.moveaxis(kv[:, :, 0:2], 2, 0)
    blocks = kv_raw[:, :, cmp_idx] + cmp_pe[:, None, None, :, None, :]
    hid = jax.nn.gelu(jnp.einsum('cbnlgd,clde->cbnge', blocks, cmp_w1))
    comp = jnp.einsum('cbnge,ced->cbngd', hid, cmp_w2)
    k_c = rms_norm(comp[0], k_norm[0])
    v_c = comp[1]
    cmp_end = jnp.asarray(np.arange(n_cmp) * D_CMP + L_CMP - 1)

    n_slc = S // L_SLC
    n_sel = min(N_SLC_SEL, n_slc)
    c0 = np.arange(n_cmp)[:, None] * D_CMP
    s0 = np.arange(n_slc)[None, :] * L_SLC
    overlap = np.minimum(c0 + L_CMP, s0 + L_SLC) - np.maximum(c0, s0)
    cmp_to_slc = jnp.asarray(np.maximum(overlap, 0) / D_CMP, dtype=jnp.float32)
    k_s = rms_norm(kv[:, :, 2], k_norm[1]).reshape(B, n_slc, L_SLC, G, dk).transpose(0, 3, 1, 2, 4)
    v_s = kv[:, :, 3].reshape(B, n_slc, L_SLC, G, dk).transpose(0, 3, 1, 2, 4)

    pad = ((0, 0), (WINDOW, 0), (0, 0), (0, 0))
    k_w = jnp.pad(rms_norm(kv[:, :, 4], k_norm[2]), pad)
    v_w = jnp.pad(kv[:, :, 5], pad)

    n_qb = S // Q_BLOCK
    q_blocks = q.reshape(B, n_qb, Q_BLOCK, G, R, dk).transpose(1, 0, 2, 3, 4, 5)
    g_blocks = jax.nn.sigmoid(gate_logits.astype(jnp.float32)).reshape(B, n_qb, Q_BLOCK, G, R, 3)
    g_blocks = g_blocks.transpose(1, 0, 2, 3, 4, 5)
    gather = jax.vmap(jax.vmap(lambda kb, i: kb[i]))

    def block(args):
        qb, qblk, gblk = args
        t = qb * Q_BLOCK + jnp.arange(Q_BLOCK)
        s = jnp.einsum('bqgrd,bngd->bgrqn', qblk, k_c) * scale
        p_c = masked_softmax(s, cmp_end[None, :] <= t[:, None])
        o_c = jnp.einsum('bgrqn,bngd->bqgrd', p_c.astype(v_c.dtype), v_c)
        imp = jnp.einsum('bgqn,nj->bgqj', jnp.sum(p_c, axis=2), cmp_to_slc)
        cur = t // L_SLC
        j = jnp.arange(n_slc)[None, :]
        forced = (j == 0) | (j == cur[:, None]) | (j == cur[:, None] - 1)
        sel_score = jnp.where(j <= cur[:, None], imp + FORCE_BONUS * forced, NEG)
        top_val, top_idx = lax.top_k(sel_score, n_sel)
        k_sel = gather(k_s, top_idx)
        v_sel = gather(v_s, top_idx)
        pos = top_idx[..., None] * L_SLC + jnp.arange(L_SLC)
        mask_s = (top_val[..., None] > 0.5 * NEG) & (pos <= t[:, None, None])
        s = jnp.einsum('bqgrd,bgqnld->bgrqnl', qblk, k_sel) * scale
        p_s = masked_softmax(s.reshape(B, G, R, Q_BLOCK, n_sel * L_SLC),
                             mask_s.reshape(B, G, 1, Q_BLOCK, n_sel * L_SLC)).reshape(s.shape)
        o_s = jnp.einsum('bgrqnl,bgqnld->bqgrd', p_s.astype(v_sel.dtype), v_sel)
        k_win = lax.dynamic_slice_in_dim(k_w, qb * Q_BLOCK, WINDOW + Q_BLOCK, axis=1)
        v_win = lax.dynamic_slice_in_dim(v_w, qb * Q_BLOCK, WINDOW + Q_BLOCK, axis=1)
        kpos = qb * Q_BLOCK - WINDOW + jnp.arange(WINDOW + Q_BLOCK)
        delta = t[:, None] - kpos[None, :]
        mask_w = (delta >= 0) & (delta < WINDOW) & (kpos[None, :] >= 0)
        s = jnp.einsum('bqgrd,bkgd->bgrqk', qblk, k_win) * scale
        p_w = masked_softmax(s, mask_w)
        o_w = jnp.einsum('bgrqk,bkgd->bqgrd', p_w.astype(v_win.dtype), v_win)
        o = (gblk[..., 0:1] * o_c + gblk[..., 1:2] * o_s + gblk[..., 2:3] * o_w)
        return o.astype(qblk.dtype)

    out = lax.map(block, (jnp.arange(n_qb), q_blocks, g_blocks))
    return out.transpose(1, 0, 2, 3, 4, 5).reshape(B, S, H * dk)


def spatial_gating(zg, ln_g, ln_b, w_s, b_s):
    B, S, _ = zg.shape
    zg = jax.nn.gelu(zg)
    u, v = jnp.split(zg, 2, axis=-1)
    v = layer_norm(v, ln_g, ln_b)
    n_ch = S // SGU_CHUNK
    v = v.reshape(B, n_ch, SGU_CHUNK, SGU_GROUPS, SGU_WIDTH // SGU_GROUPS)
    w = w_s * jnp.tril(jnp.ones((SGU_CHUNK, SGU_CHUNK), w_s.dtype))
    mixed = jnp.einsum('gts,bnsgc->bntgc', w, v) + b_s.T[:, :, None]
    return u * mixed.reshape(B, S, SGU_WIDTH)


def multiscale_pool(p, w_pool, scale):
    B, S, C = p.shape
    cg = C // len(POOL_WINDOWS)
    pf = p.astype(jnp.float32)
    csum = jnp.cumsum(pf, axis=1)
    csum_pad = jnp.pad(csum, ((0, 0), (1, 0), (0, 0)))
    pos = jnp.arange(S)
    outs = []
    for gi, w in enumerate(POOL_WINDOWS):
        sl = slice(gi * cg, (gi + 1) * cg)
        lower = jnp.pad(csum_pad[:, :S - w + 1, sl], ((0, 0), (w - 1, 0), (0, 0)))
        count = jnp.minimum(pos + 1, w).astype(jnp.float32)[None, :, None]
        outs.append((csum[:, :, sl] - lower) / count - pf[:, :, sl])
    d = jnp.stack(outs, axis=2)
    y = jnp.einsum('bsgc,gcd->bsgd', d, w_pool.astype(jnp.float32)).reshape(B, S, C) * scale
    return y.astype(p.dtype)


def memory_xattn(h, mem_h, wq, wk, wv, q_norm, k_norm, wo):
    B, S, _ = h.shape
    M = mem_h.shape[1]
    q = rms_norm((h @ wq).reshape(B, S, XA_HEADS, XA_HEAD_DIM), q_norm)
    k = rms_norm((mem_h @ wk).reshape(B, M, XA_HEADS, XA_HEAD_DIM), k_norm)
    v = (mem_h @ wv).reshape(B, M, XA_HEADS, XA_HEAD_DIM)
    s = jnp.einsum('bshd,bmhd->bhsm', q, k).astype(jnp.float32) * (XA_HEAD_DIM ** -0.5)
    p = jax.nn.softmax(s, axis=-1)
    o = jnp.einsum('bhsm,bmhd->bshd', p.astype(v.dtype), v).reshape(B, S, XA_WIDTH)
    return o @ wo


def peer_ffn(h, wq, keys1, keys2, u_tab, v_tab):
    B, S, D = h.shape
    half = PEER_QDIM // 2
    tokens = h.reshape(-1, PEER_BLOCK, D)

    def step(ht):
        T = ht.shape[0]
        q = (ht @ wq).reshape(T, PEER_HEADS, 2, half)
        s1 = jnp.einsum('thd,kd->thk', q[:, :, 0], keys1).astype(jnp.float32)
        s2 = jnp.einsum('thd,kd->thk', q[:, :, 1], keys2).astype(jnp.float32)
        v1, i1 = lax.top_k(s1, PEER_TOPK)
        v2, i2 = lax.top_k(s2, PEER_TOPK)
        cand = (v1[..., :, None] + v2[..., None, :]).reshape(T, PEER_HEADS, PEER_TOPK * PEER_TOPK)
        cv, ci = lax.top_k(cand, PEER_TOPK)
        a = jnp.take_along_axis(i1, ci // PEER_TOPK, axis=-1)
        b = jnp.take_along_axis(i2, ci % PEER_TOPK, axis=-1)
        e = a * PEER_KEYS + b
        g = jax.nn.softmax(cv, axis=-1)
        act = jax.nn.gelu(jnp.einsum('thkd,td->thk', u_tab[e], ht))
        return jnp.einsum('thk,thkd->td', (g * act).astype(ht.dtype), v_tab[e])

    return lax.map(step, tokens).reshape(B, S, D)


def setup_inputs(seed: int = 0) -> dict:
    key = jax.random.key(seed)
    ks = iter(jax.random.split(key, 40))
    f32 = jnp.float32
    L, D, dk = DEPTH, D_MODEL, NSA_HEAD_DIM
    cg = POOL_WIDTH // len(POOL_WINDOWS)

    def nrm(shape, scale):
        return jax.random.normal(next(ks), shape, f32) * scale

    def gain(shape):
        return 1.0 + 0.02 * jax.random.normal(next(ks), shape, f32)

    return {
        "x": nrm((BATCH, SEQ, D), 1.0),
        "mem": nrm((BATCH, N_MEM, D), 1.0),
        "mix_norm": gain((L, D)),
        "w_in": nrm((L, D, IN_WIDTH), D ** -0.5),
        "nsa_q_norm": gain((L, dk)),
        "nsa_k_norm": gain((L, 3, dk)),
        "cmp_pe": nrm((L, 2, L_CMP, dk), 0.5),
        "cmp_w1": nrm((L, 2, L_CMP, dk, CMP_HIDDEN), (L_CMP * dk) ** -0.5),
        "cmp_w2": nrm((L, 2, CMP_HIDDEN, dk), CMP_HIDDEN ** -0.5),
        "sgu_ln_g": gain((L, SGU_WIDTH)),
        "sgu_ln_b": nrm((L, SGU_WIDTH), 0.02),
        "sgu_w": nrm((L, SGU_GROUPS, SGU_CHUNK, SGU_CHUNK), SGU_CHUNK ** -0.5),
        "sgu_b": gain((L, SGU_GROUPS, SGU_CHUNK)),
        "pool_w": nrm((L, len(POOL_WINDOWS), cg, cg), cg ** -0.5),
        "pool_scale": gain((L, POOL_WIDTH)),
        "lift_a": nrm((L, NSA_Q_WIDTH, D), NSA_Q_WIDTH ** -0.5),
        "lift_b": nrm((L, SGU_WIDTH, D), SGU_WIDTH ** -0.5),
        "lift_c": nrm((L, POOL_WIDTH, D), POOL_WIDTH ** -0.5),
        "w_out": nrm((L, D, D), D ** -0.5),
        "xa_norm": gain((L, D)),
        "mem_norm": gain((L, D)),
        "xa_wq": nrm((L, D, XA_WIDTH), D ** -0.5),
        "xa_wk": nrm((L, D, XA_WIDTH), D ** -0.5),
        "xa_wv": nrm((L, D, XA_WIDTH), D ** -0.5),
        "xa_q_norm": gain((L, XA_HEAD_DIM)),
        "xa_k_norm": gain((L, XA_HEAD_DIM)),
        "xa_wo": nrm((L, XA_WIDTH, D), XA_WIDTH ** -0.5),
        "ffn_norm": gain((L, D)),
        "peer_wq": nrm((L, D, PEER_HEADS * PEER_QDIM), D ** -0.5),
        "peer_keys1": nrm((L, PEER_KEYS, PEER_QDIM // 2), (PEER_QDIM // 2) ** -0.5),
        "peer_keys2": nrm((L, PEER_KEYS, PEER_QDIM // 2), (PEER_QDIM // 2) ** -0.5),
        "peer_u": nrm((L, PEER_EXPERTS, D), D ** -0.5),
        "peer_v": nrm((L, PEER_EXPERTS, D), 0.25),
    }


def reference(x, mem, mix_norm, w_in, nsa_q_norm, nsa_k_norm, cmp_pe, cmp_w1, cmp_w2,
              sgu_ln_g, sgu_ln_b, sgu_w, sgu_b, pool_w, pool_scale, lift_a, lift_b, lift_c,
              w_out, xa_norm, mem_norm, xa_wq, xa_wk, xa_wv, xa_q_norm, xa_k_norm, xa_wo,
              ffn_norm, peer_wq, peer_keys1, peer_keys2, peer_u, peer_v):
    B, S, D = x.shape
    split_points = [int(c) for c in np.cumsum(IN_SPLITS)[:-1]]
    for l in range(DEPTH):
        h = rms_norm(x, mix_norm[l])
        z = h @ w_in[l]
        z_q, z_kv, z_g, z_sgu, z_pool, z_merge = jnp.split(z, split_points, axis=-1)
        o_a = nsa_attention(z_q.reshape(B, S, NSA_HEADS, NSA_HEAD_DIM),
                            z_kv.reshape(B, S, 6, NSA_KV_GROUPS, NSA_HEAD_DIM),
                            z_g.reshape(B, S, NSA_HEADS, 3),
                            nsa_q_norm[l], nsa_k_norm[l], cmp_pe[l], cmp_w1[l], cmp_w2[l])
        o_b = spatial_gating(z_sgu, sgu_ln_g[l], sgu_ln_b[l], sgu_w[l], sgu_b[l])
        o_c = multiscale_pool(z_pool, pool_w[l], pool_scale[l])
        gate = jax.nn.sigmoid(z_merge.astype(jnp.float32)).reshape(B, S, N_BRANCH, D).astype(x.dtype)
        merged = (gate[:, :, 0] * (o_a @ lift_a[l]) + gate[:, :, 1] * (o_b @ lift_b[l])
                  + gate[:, :, 2] * (o_c @ lift_c[l]))
        x = x + merged @ w_out[l]
        x = x + memory_xattn(rms_norm(x, xa_norm[l]), rms_norm(mem, mem_norm[l]),
                             xa_wq[l], xa_wk[l], xa_wv[l], xa_q_norm[l], xa_k_norm[l], xa_wo[l])
        x = x + peer_ffn(rms_norm(x, ffn_norm[l]), peer_wq[l], peer_keys1[l], peer_keys2[l],
                         peer_u[l], peer_v[l])
    return x
```

```cpp
#include <hip/hip_runtime.h>
#include <hip/hip_cooperative_groups.h>
#include <stdint.h>
#include <stdio.h>
namespace cg = cooperative_groups;

#ifndef MEGA
#define MEGA 0
#endif

#define DEV __device__ __forceinline__
typedef unsigned short bf16_t;
typedef __attribute__((ext_vector_type(8))) short bf16x8;
typedef __attribute__((ext_vector_type(4))) float f32x4;
typedef __attribute__((ext_vector_type(16))) float f32x16;
typedef __attribute__((ext_vector_type(4))) unsigned u32x4;
typedef __attribute__((ext_vector_type(2))) unsigned u32x2;

constexpr int NB = 2, S = 16384, T = NB * S, D = 1024, NL = 2;
constexpr int NZ = 2072, INW = 5144;
constexpr int ZKV = 512, ZG = 1280, ZSGU = 1304, ZPOOL = 1816;
constexpr float EPS = 1e-6f;
constexpr float LOG2E = 1.4426950408889634f;

enum { I_X = 0, I_MEM, I_MIXN, I_WIN, I_QN, I_KN, I_PE, I_W1, I_W2, I_LNG, I_LNB, I_SGUW, I_SGUB, I_POOLW, I_POOLS,
       I_LA, I_LB, I_LC, I_WOUT, I_XAN, I_MEMN, I_XWQ, I_XWK, I_XWV, I_XQN, I_XKN, I_XWO, I_FFN, I_PWQ, I_K1, I_K2, I_PU, I_PV, N_IN };

constexpr size_t MiB = 1ull << 20;
constexpr size_t O_WINT = 1 * MiB;
constexpr size_t O_LAT = 22 * MiB;
constexpr size_t O_LBT = 24 * MiB;
constexpr size_t O_LCT = 25 * MiB;
constexpr size_t O_WOT = 26 * MiB;
constexpr size_t O_XWQT = 30 * MiB;
constexpr size_t O_XWKT = 32 * MiB;
constexpr size_t O_XWVT = 34 * MiB;
constexpr size_t O_XWOT = 36 * MiB;
constexpr size_t O_PWQT = 38 * MiB;
constexpr size_t O_W1T = 42 * MiB;
constexpr size_t O_POOLT = 44 * MiB;
constexpr size_t O_SGUW = O_POOLT + 65536;
constexpr size_t O_KEYS = O_SGUW + 262144;
constexpr size_t O_PW1 = O_KEYS + 65536;
constexpr size_t O_MEMH = 45 * MiB;
constexpr size_t O_XKVT = 47 * MiB;
constexpr size_t O_XK = 51 * MiB;
constexpr size_t O_XVT = 52 * MiB;
constexpr size_t O_HID = 53 * MiB;
constexpr size_t O_KC = 55 * MiB;
constexpr size_t O_VCT = O_KC + 524288;
constexpr size_t O_GATE = 56 * MiB;
constexpr size_t O_XN = 60 * MiB;
constexpr size_t O_ZBUF = 124 * MiB;
constexpr size_t O_MERGED = O_ZBUF;
constexpr size_t O_PQ = O_ZBUF + 64 * MiB;
constexpr size_t O_QN = 254 * MiB;
constexpr size_t O_XAQ = O_QN;
constexpr size_t O_KSLC = 286 * MiB;
constexpr size_t O_KWIN = 294 * MiB;
constexpr size_t O_VSLCT = 302 * MiB;
constexpr size_t O_VWINT = 310 * MiB;
constexpr size_t O_UG = 318 * MiB;
constexpr size_t O_VLN = 334 * MiB;
constexpr size_t O_DPOOL = 350 * MiB;
constexpr size_t O_PTOP = O_UG;
constexpr size_t O_OA = 366 * MiB;
constexpr size_t O_XAO = O_OA;
constexpr size_t O_OB = 398 * MiB;
constexpr size_t O_OC = 414 * MiB;
constexpr size_t O_PU = 430 * MiB;
constexpr size_t O_PVB = 462 * MiB;
constexpr size_t WS_NEED = 494 * MiB;

struct Args {
    const float* in[N_IN];
    float* out;
    unsigned char* ws;
    int ph_lo, ph_hi;
};

DEV float bflo(unsigned w) { return __uint_as_float(w << 16); }
DEV float bfhi(unsigned w) { return __uint_as_float(w & 0xffff0000u); }
DEV unsigned f2bf(float f) { unsigned u = __float_as_uint(f); return (u + 0x7fffu + ((u >> 16) & 1u)) >> 16; }
DEV unsigned pk2(float lo, float hi) { return f2bf(lo) | (f2bf(hi) << 16); }
DEV float wsum(float v) {
#pragma unroll
    for (int o = 32; o >= 1; o >>= 1) v += __shfl_xor(v, o);
    return v;
}
DEV float wmaxf(float v) {
#pragma unroll
    for (int o = 32; o >= 1; o >>= 1) v = fmaxf(v, __shfl_xor(v, o));
    return v;
}
DEV float gelu_t(float x) {
    float u = 0.7978845608028654f * (x + 0.044715f * x * x * x);
    return x / (1.f + __expf(-2.f * u));
}
DEV float sigmoidf_(float x) { return 1.f / (1.f + __expf(-x)); }
DEV unsigned f2sort(float f) { unsigned u = __float_as_uint(f); return (u & 0x80000000u) ? ~u : (u | 0x80000000u); }
DEV float sort2f(unsigned s) { unsigned u = (s & 0x80000000u) ? (s & 0x7fffffffu) : ~s; return __uint_as_float(u); }
DEV void unpack8(u32x4 r, float* f) {
    f[0] = bflo(r.x); f[1] = bfhi(r.x); f[2] = bflo(r.y); f[3] = bfhi(r.y);
    f[4] = bflo(r.z); f[5] = bfhi(r.z); f[6] = bflo(r.w); f[7] = bfhi(r.w);
}
DEV f32x4 mfma16(bf16x8 a, bf16x8 b, f32x4 c) { return __builtin_amdgcn_mfma_f32_16x16x32_bf16(a, b, c, 0, 0, 0); }
DEV f32x16 mfma32(bf16x8 a, bf16x8 b, f32x16 c) { return __builtin_amdgcn_mfma_f32_32x32x16_bf16(a, b, c, 0, 0, 0); }
DEV bf16x8 ld8(const bf16_t* p) { return *(const bf16x8*)p; }
DEV void lds_fence() { asm volatile("s_waitcnt lgkmcnt(0)" ::: "memory"); }

DEV void transpose_cvt(unsigned char* smem, const float* __restrict__ W, int K, int N, bf16_t* __restrict__ WT, int ldt) {
    float* tile = (float*)smem;
    const int tk = (K + 63) / 64, tn = (N + 63) / 64;
    for (int it = blockIdx.x; it < tk * tn; it += gridDim.x) {
        const int k0 = (it / tn) * 64, n0 = (it % tn) * 64;
        __syncthreads();
        for (int idx = threadIdx.x; idx < 4096; idx += 256) {
            const int k = idx >> 6, n = idx & 63;
            float v = 0.f;
            if (k0 + k < K && n0 + n < N) v = W[(size_t)(k0 + k) * N + n0 + n];
            tile[k * 65 + n] = v;
        }
        __syncthreads();
        for (int idx = threadIdx.x; idx < 4096; idx += 256) {
            const int n = idx >> 6, k = idx & 63;
            if (k0 + k < K && n0 + n < N) WT[(size_t)(n0 + n) * ldt + k0 + k] = (bf16_t)f2bf(tile[k * 65 + n]);
        }
    }
}

DEV void rmsnorm_rows(const float* __restrict__ X, const float* __restrict__ g, bf16_t* __restrict__ Y, int rows) {
    const int wave = threadIdx.x >> 6, lane = threadIdx.x & 63;
    for (int r = blockIdx.x * 4 + wave; r < rows; r += gridDim.x * 4) {
        const float4* xr = (const float4*)(X + (size_t)r * 1024);
        float4 v[4];
        float ss = 0.f;
#pragma unroll
        for (int i = 0; i < 4; ++i) { v[i] = xr[lane + 64 * i]; ss += v[i].x * v[i].x + v[i].y * v[i].y + v[i].z * v[i].z + v[i].w * v[i].w; }
        ss = wsum(ss);
        const float rs = rsqrtf(ss * (1.f / 1024.f) + EPS);
#pragma unroll
        for (int i = 0; i < 4; ++i) {
            const float4 gg = ((const float4*)g)[lane + 64 * i];
            u32x2 o;
            o.x = pk2(v[i].x * rs * gg.x, v[i].y * rs * gg.y);
            o.y = pk2(v[i].z * rs * gg.z, v[i].w * rs * gg.w);
            *(u32x2*)(Y + (size_t)r * 1024 + (lane + 64 * i) * 4) = o;
        }
    }
}

template <int MI, int NI, bool BKN, class AF, class BF>
DEV void gemm_kloop(unsigned char* smem, int K, AF arow, BF brow, f32x16 (&acc)[MI][NI]) {
    constexpr int BM = 64 * MI, BN = 64 * NI;
    constexpr int LA = BM / 32, LB = BN / 32;
    bf16_t* As = (bf16_t*)smem;
    bf16_t* Bs = As + BM * 72;
    const int tid = threadIdx.x, lane = tid & 63, wave = tid >> 6, wm = wave >> 1, wn = wave & 1;
    const int lr = tid >> 3, ls = (tid & 7) * 8;
    u32x4 ra[LA], rb[LB];
#pragma unroll
    for (int i = 0; i < LA; ++i) ra[i] = *(const u32x4*)(arow(lr + 32 * i, 0) + ls);
#pragma unroll
    for (int i = 0; i < LB; ++i) rb[i] = *(const u32x4*)(brow(lr + 32 * i, 0) + ls);
    for (int k0 = 0; k0 < K; k0 += 64) {
        __syncthreads();
#pragma unroll
        for (int i = 0; i < LA; ++i) *(u32x4*)(As + (lr + 32 * i) * 72 + ls) = ra[i];
        if (!BKN) {
#pragma unroll
            for (int i = 0; i < LB; ++i) *(u32x4*)(Bs + (lr + 32 * i) * 72 + ls) = rb[i];
        } else {
#pragma unroll
            for (int i = 0; i < LB; ++i) {
                const int kl = lr + 32 * i;
                const unsigned w[4] = {rb[i].x, rb[i].y, rb[i].z, rb[i].w};
#pragma unroll
                for (int e = 0; e < 4; ++e) {
                    Bs[(ls + 2 * e) * 72 + kl] = (bf16_t)(w[e] & 0xffffu);
                    Bs[(ls + 2 * e + 1) * 72 + kl] = (bf16_t)(w[e] >> 16);
                }
            }
        }
        __syncthreads();
        if (k0 + 64 < K) {
#pragma unroll
            for (int i = 0; i < LA; ++i) ra[i] = *(const u32x4*)(arow(lr + 32 * i, k0 + 64) + ls);
#pragma unroll
            for (int i = 0; i < LB; ++i) rb[i] = *(const u32x4*)(brow(lr + 32 * i, k0 + 64) + ls);
        }
#pragma unroll
        for (int kk = 0; kk < 4; ++kk) {
            bf16x8 af[MI], bfr[NI];
#pragma unroll
            for (int mi = 0; mi < MI; ++mi) af[mi] = ld8(As + (wm * 32 * MI + mi * 32 + (lane & 31)) * 72 + kk * 16 + (lane >> 5) * 8);
#pragma unroll
            for (int ni = 0; ni < NI; ++ni) bfr[ni] = ld8(Bs + (wn * 32 * NI + ni * 32 + (lane & 31)) * 72 + kk * 16 + (lane >> 5) * 8);
#pragma unroll
            for (int mi = 0; mi < MI; ++mi)
#pragma unroll
                for (int ni = 0; ni < NI; ++ni) acc[mi][ni] = mfma32(af[mi], bfr[ni], acc[mi][ni]);
        }
    }
}
template <int MI, int NI>
DEV void acc_zero(f32x16 (&acc)[MI][NI]) {
#pragma unroll
    for (int mi = 0; mi < MI; ++mi)
#pragma unroll
        for (int ni = 0; ni < NI; ++ni)
#pragma unroll
            for (int r = 0; r < 16; ++r) acc[mi][ni][r] = 0.f;
}
template <int MI, int NI, class EF>
DEV void gemm_epi(f32x16 (&acc)[MI][NI], EF epi) {
    const int lane = threadIdx.x & 63, wave = threadIdx.x >> 6, wm = wave >> 1, wn = wave & 1;
#pragma unroll
    for (int mi = 0; mi < MI; ++mi)
#pragma unroll
        for (int ni = 0; ni < NI; ++ni)
#pragma unroll
            for (int r = 0; r < 16; ++r) {
                const int row = wm * 32 * MI + mi * 32 + (r & 3) + 8 * (r >> 2) + 4 * (lane >> 5);
                const int col = wn * 32 * NI + ni * 32 + (lane & 31);
                epi(row, col, acc[mi][ni][r]);
            }
}


#define WSP(T_, off) ((T_*)(a.ws + (off)))

DEV void ph_prep(const Args& a, unsigned char* smem) {
    for (int l = 0; l < NL; ++l) {
        transpose_cvt(smem, a.in[I_WIN] + (size_t)l * 1024 * INW, 1024, INW, WSP(bf16_t, O_WINT) + (size_t)l * INW * 1024, 1024);
        transpose_cvt(smem, a.in[I_LA] + (size_t)l * 512 * 1024, 512, 1024, WSP(bf16_t, O_LAT) + (size_t)l * 1024 * 512, 512);
        transpose_cvt(smem, a.in[I_LB] + (size_t)l * 256 * 1024, 256, 1024, WSP(bf16_t, O_LBT) + (size_t)l * 1024 * 256, 256);
        transpose_cvt(smem, a.in[I_LC] + (size_t)l * 256 * 1024, 256, 1024, WSP(bf16_t, O_LCT) + (size_t)l * 1024 * 256, 256);
        transpose_cvt(smem, a.in[I_WOUT] + (size_t)l * 1024 * 1024, 1024, 1024, WSP(bf16_t, O_WOT) + (size_t)l * 1024 * 1024, 1024);
        transpose_cvt(smem, a.in[I_XWQ] + (size_t)l * 1024 * 512, 1024, 512, WSP(bf16_t, O_XWQT) + (size_t)l * 512 * 1024, 1024);
        transpose_cvt(smem, a.in[I_XWK] + (size_t)l * 1024 * 512, 1024, 512, WSP(bf16_t, O_XWKT) + (size_t)l * 512 * 1024, 1024);
        transpose_cvt(smem, a.in[I_XWV] + (size_t)l * 1024 * 512, 1024, 512, WSP(bf16_t, O_XWVT) + (size_t)l * 512 * 1024, 1024);
        transpose_cvt(smem, a.in[I_XWO] + (size_t)l * 512 * 1024, 512, 1024, WSP(bf16_t, O_XWOT) + (size_t)l * 1024 * 512, 512);
        transpose_cvt(smem, a.in[I_PWQ] + (size_t)l * 1024 * 1024, 1024, 1024, WSP(bf16_t, O_PWQT) + (size_t)l * 1024 * 1024, 1024);
        for (int c = 0; c < 2; ++c)
            transpose_cvt(smem, a.in[I_W1] + (size_t)(l * 2 + c) * 2048 * 128, 2048, 128, WSP(bf16_t, O_W1T) + (size_t)(l * 2 + c) * 128 * 2048, 2048);
        for (int g = 0; g < 4; ++g)
            transpose_cvt(smem, a.in[I_POOLW] + (size_t)(l * 4 + g) * 4096, 64, 64, WSP(bf16_t, O_POOLT) + (size_t)(l * 4 + g) * 4096, 64);
    }
    const int gtid = blockIdx.x * 256 + threadIdx.x, gsz = gridDim.x * 256;
    {
        bf16_t* o = WSP(bf16_t, O_SGUW);
        const float* w = a.in[I_SGUW];
        for (int idx = gtid; idx < NL * 4 * 128 * 128; idx += gsz) {
            const int t = (idx >> 7) & 127, s = idx & 127;
            o[idx] = (bf16_t)f2bf(s <= t ? w[idx] : 0.f);
        }
    }
    {
        bf16_t* o = WSP(bf16_t, O_KEYS);
        for (int idx = gtid; idx < NL * 2 * 8192; idx += gsz) {
            const int l = idx >> 14, half = (idx >> 13) & 1, rem = idx & 8191;
            o[idx] = (bf16_t)f2bf((half ? a.in[I_K2] : a.in[I_K1])[l * 8192 + rem]);
        }
    }
    {
        float* o = WSP(float, O_PW1);
        for (int idx = gtid; idx < NL * 2 * 128; idx += gsz) {
            const int lc = idx >> 7, e = idx & 127;
            const float* pe = a.in[I_PE] + (size_t)lc * 2048;
            const float* w1 = a.in[I_W1] + (size_t)lc * 2048 * 128 + e;
            float s = 0.f;
            for (int k = 0; k < 2048; ++k) s += pe[k] * w1[(size_t)k * 128];
            o[idx] = s;
        }
    }
}

DEV void ph_peercvt(const Args& a, int l) {
    const int gtid = blockIdx.x * 256 + threadIdx.x, gsz = gridDim.x * 256;
    for (int tb = 0; tb < 2; ++tb) {
        const float4* src = (const float4*)((tb ? a.in[I_PV] : a.in[I_PU]) + (size_t)l * 16384 * 1024);
        u32x2* dst = (u32x2*)(a.ws + (tb ? O_PVB : O_PU));
        for (int i = gtid; i < 16384 * 1024 / 4; i += gsz) {
            const float4 v = src[i];
            u32x2 o; o.x = pk2(v.x, v.y); o.y = pk2(v.z, v.w);
            dst[i] = o;
        }
    }
}

DEV void ph_mem1(const Args& a) {
    for (int l = 0; l < NL; ++l)
        rmsnorm_rows(a.in[I_MEM], a.in[I_MEMN] + l * 1024, WSP(bf16_t, O_MEMH) + (size_t)l * 512 * 1024, 512);
}
DEV void ph_mem2(const Args& a, unsigned char* smem) {
    for (int it = blockIdx.x; it < 64; it += gridDim.x) {
        const int l = it >> 5, which = (it >> 4) & 1, mt = (it >> 2) & 3, nt = it & 3;
        const bf16_t* A = WSP(bf16_t, O_MEMH) + (size_t)l * 512 * 1024 + (size_t)mt * 128 * 1024;
        const bf16_t* Bt = WSP(bf16_t, which ? O_XWVT : O_XWKT) + (size_t)l * 512 * 1024 + (size_t)nt * 128 * 1024;
        float* o = WSP(float, O_XKVT) + (size_t)(l * 2 + which) * 512 * 512;
        f32x16 acc[2][2];
        acc_zero(acc);
        gemm_kloop<2, 2, false>(smem, 1024, [&](int r, int k0) { return A + (size_t)r * 1024 + k0; },
                                [&](int n, int k0) { return Bt + (size_t)n * 1024 + k0; }, acc);
        gemm_epi<2, 2>(acc, [&](int row, int col, float v) { o[(size_t)(mt * 128 + row) * 512 + nt * 128 + col] = v; });
    }
}
DEV void ph_mem3(const Args& a) {
    const int wave = threadIdx.x >> 6, lane = threadIdx.x & 63;
    for (int rw = blockIdx.x * 4 + wave; rw < NL * 512; rw += gridDim.x * 4) {
        const int l = rw >> 9, r = rw & 511, b = r >> 8, m = r & 255;
        const float* kr = WSP(float, O_XKVT) + ((size_t)(l * 2 + 0) * 512 + r) * 512 + lane * 8;
        const float* vr = WSP(float, O_XKVT) + ((size_t)(l * 2 + 1) * 512 + r) * 512 + lane * 8;
        const int h = lane >> 4, d0 = (lane & 15) * 8;
        const float* kn = a.in[I_XKN] + l * 128;
        float f[8], ss = 0.f;
#pragma unroll
        for (int i = 0; i < 8; ++i) { f[i] = kr[i]; ss += f[i] * f[i]; }
        ss += __shfl_xor(ss, 1); ss += __shfl_xor(ss, 2); ss += __shfl_xor(ss, 4); ss += __shfl_xor(ss, 8);
        const float rs = rsqrtf(ss * (1.f / 128.f) + EPS);
        u32x4 o;
        o.x = pk2(f[0] * rs * kn[d0 + 0], f[1] * rs * kn[d0 + 1]);
        o.y = pk2(f[2] * rs * kn[d0 + 2], f[3] * rs * kn[d0 + 3]);
        o.z = pk2(f[4] * rs * kn[d0 + 4], f[5] * rs * kn[d0 + 5]);
        o.w = pk2(f[6] * rs * kn[d0 + 6], f[7] * rs * kn[d0 + 7]);
        *(u32x4*)(WSP(bf16_t, O_XK) + ((size_t)((l * 2 + b) * 4 + h) * 256 + m) * 128 + d0) = o;
        bf16_t* vt = WSP(bf16_t, O_XVT) + ((size_t)((l * 2 + b) * 4 + h) * 128 + d0) * 256 + m;
#pragma unroll
        for (int i = 0; i < 8; ++i) vt[(size_t)i * 256] = (bf16_t)f2bf(vr[i]);
    }
}

DEV void ph_gemm1(const Args& a, int l, unsigned char* smem) {
    const bf16_t* A = WSP(bf16_t, O_XN);
    const bf16_t* Bt = WSP(bf16_t, O_WINT) + (size_t)l * INW * 1024;
    bf16_t* z = WSP(bf16_t, O_ZBUF);
    constexpr int NT = 17;
    for (int it = blockIdx.x; it < 256 * NT; it += gridDim.x) {
        const int mt = it / NT, nt = it % NT;
        const int m0 = mt * 128, n0 = nt * 128;
        f32x16 acc[2][2];
        acc_zero(acc);
        gemm_kloop<2, 2, false>(smem, 1024, [&](int r, int k0) { return A + (size_t)(m0 + r) * 1024 + k0; },
                                [&](int n, int k0) { return Bt + (size_t)(n0 + n) * 1024 + k0; }, acc);
        gemm_epi<2, 2>(acc, [&](int row, int col, float v) {
            if (n0 + col < NZ) z[(size_t)(m0 + row) * NZ + n0 + col] = (bf16_t)f2bf(v);
        });
    }
}

DEV void ph_post(const Args& a, int l, unsigned char* smem) {
    const bf16_t* zb = WSP(bf16_t, O_ZBUF);
    bf16_t* vt = (bf16_t*)smem;
    const float* qnw = a.in[I_QN] + l * 64;
    const float* knw = a.in[I_KN] + l * 192;
    const float* lng = a.in[I_LNG] + l * 256;
    const float* lnb = a.in[I_LNB] + l * 256;
    const int tid = threadIdx.x, wave = tid >> 6, lane = tid & 63;
    for (int it = blockIdx.x; it < T / 64; it += gridDim.x) {
        const int t0 = it * 64, b = t0 / S, s0 = t0 - b * S;
        __syncthreads();
        for (int i = 0; i < 16; ++i) {
            const int tl = wave * 16 + i, t = t0 + tl, s = s0 + tl;
            const bf16_t* row = zb + (size_t)t * NZ;
            {
                const u32x4 r = *(const u32x4*)(row + 8 * lane);
                float f[8]; unpack8(r, f);
                float ss = 0.f;
#pragma unroll
                for (int e = 0; e < 8; ++e) ss += f[e] * f[e];
                ss += __shfl_xor(ss, 1); ss += __shfl_xor(ss, 2); ss += __shfl_xor(ss, 4);
                const float rs = rsqrtf(ss * (1.f / 64.f) + EPS) * (0.125f * LOG2E);
                const int d0 = (lane & 7) * 8;
                u32x4 o;
                o.x = pk2(f[0] * rs * qnw[d0 + 0], f[1] * rs * qnw[d0 + 1]);
                o.y = pk2(f[2] * rs * qnw[d0 + 2], f[3] * rs * qnw[d0 + 3]);
                o.z = pk2(f[4] * rs * qnw[d0 + 4], f[5] * rs * qnw[d0 + 5]);
                o.w = pk2(f[6] * rs * qnw[d0 + 6], f[7] * rs * qnw[d0 + 7]);
                *(u32x4*)(WSP(bf16_t, O_QN) + (size_t)t * 512 + 8 * lane) = o;
            }
            {
                const u32x4 r = *(const u32x4*)(row + 768 + 8 * lane);
                const int c6 = 2 + (lane >> 4), g = (lane >> 3) & 1, d0 = (lane & 7) * 8;
                float f[8]; unpack8(r, f);
                float ss = 0.f;
#pragma unroll
                for (int e = 0; e < 8; ++e) ss += f[e] * f[e];
                ss += __shfl_xor(ss, 1); ss += __shfl_xor(ss, 2); ss += __shfl_xor(ss, 4);
                if ((c6 & 1) == 0) {
                    const float* kn = knw + (c6 == 2 ? 64 : 128);
                    const float rs = rsqrtf(ss * (1.f / 64.f) + EPS);
                    u32x4 o;
                    o.x = pk2(f[0] * rs * kn[d0 + 0], f[1] * rs * kn[d0 + 1]);
                    o.y = pk2(f[2] * rs * kn[d0 + 2], f[3] * rs * kn[d0 + 3]);
                    o.z = pk2(f[4] * rs * kn[d0 + 4], f[5] * rs * kn[d0 + 5]);
                    o.w = pk2(f[6] * rs * kn[d0 + 6], f[7] * rs * kn[d0 + 7]);
                    bf16_t* dst = WSP(bf16_t, c6 == 2 ? O_KSLC : O_KWIN) + ((size_t)((b * 2 + g) * S + s)) * 64 + d0;
                    *(u32x4*)dst = o;
                } else {
                    const int which = (c6 - 3) >> 1;
                    bf16_t* dst = vt + ((which * 2 + g) * 64 + d0) * 72 + tl;
                    const unsigned w[4] = {r.x, r.y, r.z, r.w};
#pragma unroll
                    for (int e = 0; e < 4; ++e) {
                        dst[(2 * e) * 72] = (bf16_t)(w[e] & 0xffffu);
                        dst[(2 * e + 1) * 72] = (bf16_t)(w[e] >> 16);
                    }
                }
            }
            if (lane < 24) {
                const float z = bflo((unsigned)row[ZG + lane]);
                WSP(float, O_GATE)[(size_t)t * 24 + lane] = sigmoidf_(z);
            }
            {
                const u32x4 r = *(const u32x4*)(row + ZSGU + 8 * lane);
                float f[8]; unpack8(r, f);
                float sm = 0.f;
#pragma unroll
                for (int e = 0; e < 8; ++e) { f[e] = gelu_t(f[e]); sm += f[e]; }
#pragma unroll
                for (int o = 1; o <= 16; o <<= 1) sm += __shfl_xor(sm, o);
                const float mu = sm * (1.f / 256.f);
                float vr = 0.f;
#pragma unroll
                for (int e = 0; e < 8; ++e) vr += (f[e] - mu) * (f[e] - mu);
#pragma unroll
                for (int o = 1; o <= 16; o <<= 1) vr += __shfl_xor(vr, o);
                const float rs = rsqrtf(vr * (1.f / 256.f) + EPS);
                u32x4 o;
                if (lane < 32) {
                    o.x = pk2(f[0], f[1]); o.y = pk2(f[2], f[3]); o.z = pk2(f[4], f[5]); o.w = pk2(f[6], f[7]);
                    *(u32x4*)(WSP(bf16_t, O_UG) + (size_t)t * 256 + 8 * lane) = o;
                } else {
                    const int c0 = 8 * (lane - 32);
                    float y[8];
#pragma unroll
                    for (int e = 0; e < 8; ++e) y[e] = (f[e] - mu) * rs * lng[c0 + e] + lnb[c0 + e];
                    o.x = pk2(y[0], y[1]); o.y = pk2(y[2], y[3]); o.z = pk2(y[4], y[5]); o.w = pk2(y[6], y[7]);
                    *(u32x4*)(WSP(bf16_t, O_VLN) + (size_t)t * 256 + c0) = o;
                }
            }
            if (lane < 32) {
                const int gi = lane >> 3, w = 2 << gi, c0 = 8 * lane;
                float acc[8], p[8];
#pragma unroll
                for (int e = 0; e < 8; ++e) acc[e] = 0.f;
                for (int k = 0; k < 16; ++k) {
                    if (k < w && s - k >= 0) {
                        const u32x4 r = *(const u32x4*)(row - (size_t)k * NZ + ZPOOL + c0);
                        float f[8]; unpack8(r, f);
#pragma unroll
                        for (int e = 0; e < 8; ++e) { acc[e] += f[e]; if (k == 0) p[e] = f[e]; }
                    }
                }
                const float ic = 1.f / (float)min(s + 1, w);
                u32x4 o;
                o.x = pk2(acc[0] * ic - p[0], acc[1] * ic - p[1]);
                o.y = pk2(acc[2] * ic - p[2], acc[3] * ic - p[3]);
                o.z = pk2(acc[4] * ic - p[4], acc[5] * ic - p[5]);
                o.w = pk2(acc[6] * ic - p[6], acc[7] * ic - p[7]);
                *(u32x4*)(WSP(bf16_t, O_DPOOL) + (size_t)t * 256 + c0) = o;
            }
        }
        __syncthreads();
        {
            const int which = tid >> 7, g = (tid >> 6) & 1, d = tid & 63;
            const bf16_t* src = vt + tid * 72;
            bf16_t* dst = WSP(bf16_t, which ? O_VWINT : O_VSLCT) + ((size_t)((b * 2 + g) * 64 + d)) * S + s0;
#pragma unroll
            for (int j = 0; j < 8; ++j) *(u32x4*)(dst + 8 * j) = *(const u32x4*)(src + 8 * j);
        }
    }
}

DEV void ph_cmp1(const Args& a, int l, unsigned char* smem) {
    const bf16_t* zb = WSP(bf16_t, O_ZBUF);
    const bf16_t* W1T = WSP(bf16_t, O_W1T) + (size_t)(l * 2) * 128 * 2048;
    const float* pw1 = WSP(float, O_PW1) + l * 256;
    bf16_t* hid = WSP(bf16_t, O_HID);
    for (int it = blockIdx.x; it < 256; it += gridDim.x) {
        const int c = it >> 7, mt = (it >> 1) & 63, nt = it & 1, m0 = mt * 64, n0 = nt * 64;
        f32x16 acc[1][1];
        acc_zero(acc);
        gemm_kloop<1, 1, false>(smem, 2048,
            [&](int r, int k0) {
                const int m = m0 + r, bg = m >> 10, n = min(m & 1023, 1022), b = bg >> 1, g = bg & 1;
                return zb + ((size_t)(b * S + 16 * n + (k0 >> 6))) * NZ + ZKV + c * 128 + g * 64;
            },
            [&](int n, int k0) { return W1T + ((size_t)(c * 128 + n0 + n)) * 2048 + k0; }, acc);
        gemm_epi<1, 1>(acc, [&](int row, int col, float v) {
            hid[((size_t)(c * 4096 + m0 + row)) * 128 + n0 + col] = (bf16_t)f2bf(gelu_t(v + pw1[c * 128 + n0 + col]));
        });
    }
}
DEV void ph_cmp2(const Args& a, int l) {
    const float* w2 = a.in[I_W2] + (size_t)l * 2 * 128 * 64;
    const float* kn0 = a.in[I_KN] + l * 192;
    const bf16_t* hid = WSP(bf16_t, O_HID);
    const int wave = threadIdx.x >> 6, lane = threadIdx.x & 63;
    for (int rw = blockIdx.x * 4 + wave; rw < 8192; rw += gridDim.x * 4) {
        const int c = rw >> 12, m = rw & 4095, bg = m >> 10, n = m & 1023;
        const bf16_t* h = hid + ((size_t)(c * 4096 + m)) * 128;
        float acc = 0.f;
        for (int e = 0; e < 128; ++e) acc += bflo((unsigned)h[e]) * w2[(c * 128 + e) * 64 + lane];
        if (c == 0) {
            const float ss = wsum(acc * acc);
            const float v = acc * rsqrtf(ss * (1.f / 64.f) + EPS) * kn0[lane];
            WSP(bf16_t, O_KC)[((size_t)(bg * 1024 + n)) * 64 + lane] = (n < 1023) ? (bf16_t)f2bf(v) : (bf16_t)0;
        } else {
            WSP(bf16_t, O_VCT)[((size_t)(bg * 64 + lane)) * 1024 + n] = (n < 1023) ? (bf16_t)f2bf(acc) : (bf16_t)0;
        }
    }
}

DEV bf16x8 packp(const float* pa, const float* pb) {
    u32x4 w;
    w.x = pk2(pa[0], pa[1]); w.y = pk2(pa[2], pa[3]); w.z = pk2(pb[0], pb[1]); w.w = pk2(pb[2], pb[3]);
    return __builtin_bit_cast(bf16x8, w);
}
DEV void ph_nsa(const Args& a, int l, unsigned char* smem) {
    const int tid = threadIdx.x, wave = tid >> 6, lane = tid & 63, col = lane & 15, q4 = lane >> 4, qq = col >> 2, r = col & 3;
    const bf16_t* qn = WSP(bf16_t, O_QN);
    const float* gate = WSP(float, O_GATE);
    bf16_t* oa = WSP(bf16_t, O_OA);
    float M0;
    {
        const float* kn = a.in[I_KN] + l * 192;
        const float gq = wmaxf(fabsf(a.in[I_QN][l * 64 + lane]));
        const float gk = wmaxf(fmaxf(fabsf(kn[lane]), fmaxf(fabsf(kn[64 + lane]), fabsf(kn[128 + lane]))));
        M0 = 8.f * gq * gk * LOG2E * 1.01f;
    }
    float* imp = (float*)smem + wave * 1104;
    int* sel = (int*)(imp + 1040);
    const int ia = 8 * (col >> 2) + (col & 3);
    for (int it = blockIdx.x; it < 4096; it += gridDim.x) {
        const int bg = it & 3, tt = 1023 - (it >> 2), b = bg >> 1, g = bg & 1;
        const int t0 = tt * 16 + wave * 4;
        const int t = t0 + qq;
        const int h = g * 4 + r;
        const size_t tok = (size_t)b * S + t;
        bf16x8 qf[2];
#pragma unroll
        for (int ks = 0; ks < 2; ++ks) qf[ks] = ld8(qn + tok * 512 + h * 64 + ks * 32 + q4 * 8);
        const float* gp = gate + tok * 24 + h * 3;
        const float g0 = gp[0], g1 = gp[1], g2 = gp[2];
        f32x4 otot[4];
#pragma unroll
        for (int dt = 0; dt < 4; ++dt) otot[dt] = (f32x4){0.f, 0.f, 0.f, 0.f};

        const int tmax = t0 + 3;
        const int nvis = tmax >= 31 ? ((tmax - 31) >> 4) + 1 : 0;
        const int ng = (nvis + 31) >> 5;
        const bf16_t* kcb = WSP(bf16_t, O_KC) + (size_t)bg * 1024 * 64;
        const bf16_t* vcb = WSP(bf16_t, O_VCT) + (size_t)bg * 64 * 1024;
        float linv_c;
        {
            f32x4 o[4];
#pragma unroll
            for (int dt = 0; dt < 4; ++dt) o[dt] = (f32x4){0.f, 0.f, 0.f, 0.f};
            float ls = 0.f;
            for (int G = 0; G < ng; ++G) {
                const int kb0 = 32 * G;
                f32x4 sa = {0.f, 0.f, 0.f, 0.f}, sb = {0.f, 0.f, 0.f, 0.f};
#pragma unroll
                for (int ks = 0; ks < 2; ++ks) {
                    const bf16x8 ka = ld8(kcb + (size_t)(kb0 + ia) * 64 + ks * 32 + q4 * 8);
                    const bf16x8 kb = ld8(kcb + (size_t)(kb0 + ia + 4) * 64 + ks * 32 + q4 * 8);
                    sa = mfma16(ka, qf[ks], sa);
                    sb = mfma16(kb, qf[ks], sb);
                }
                float pa[4], pb[4];
#pragma unroll
                for (int e = 0; e < 4; ++e) {
                    const int n = kb0 + 8 * q4 + e;
                    pa[e] = (16 * n + 31 <= t) ? exp2f(sa[e] - M0) : 0.f;
                    pb[e] = (16 * (n + 4) + 31 <= t) ? exp2f(sb[e] - M0) : 0.f;
                    ls += pa[e] + pb[e];
                }
                const bf16x8 pf = packp(pa, pb);
#pragma unroll
                for (int dt = 0; dt < 4; ++dt) {
                    const bf16x8 va = ld8(vcb + (size_t)(dt * 16 + col) * 1024 + kb0 + q4 * 8);
                    o[dt] = mfma16(va, pf, o[dt]);
                }
            }
            ls += __shfl_xor(ls, 16);
            ls += __shfl_xor(ls, 32);
            linv_c = ls > 0.f ? 1.f / ls : 0.f;
#pragma unroll
            for (int dt = 0; dt < 4; ++dt) otot[dt] = o[dt] * (g0 * linv_c);
        }
        for (int i = lane; i < 1040; i += 64) imp[i] = 0.f;
        lds_fence();
        for (int G = 0; G < ng; ++G) {
            const int kb0 = 32 * G;
            f32x4 sa = {0.f, 0.f, 0.f, 0.f}, sb = {0.f, 0.f, 0.f, 0.f};
#pragma unroll
            for (int ks = 0; ks < 2; ++ks) {
                const bf16x8 ka = ld8(kcb + (size_t)(kb0 + ia) * 64 + ks * 32 + q4 * 8);
                const bf16x8 kb = ld8(kcb + (size_t)(kb0 + ia + 4) * 64 + ks * 32 + q4 * 8);
                sa = mfma16(ka, qf[ks], sa);
                sb = mfma16(kb, qf[ks], sb);
            }
            float p[8];
#pragma unroll
            for (int e = 0; e < 4; ++e) {
                const int n = kb0 + 8 * q4 + e;
                p[e] = (16 * n + 31 <= t) ? exp2f(sa[e] - M0) * linv_c : 0.f;
                p[e + 4] = (16 * (n + 4) + 31 <= t) ? exp2f(sb[e] - M0) * linv_c : 0.f;
            }
#pragma unroll
            for (int e = 0; e < 8; ++e) { p[e] += __shfl_xor(p[e], 1); p[e] += __shfl_xor(p[e], 2); }
            if (r == 0) {
                const int j0 = 8 * G + 2 * q4;
                float* ip = imp + qq * 260 + j0;
                atomicAdd(ip, 2.f * (p[0] + p[1] + p[2]) + p[3]);
                atomicAdd(ip + 1, p[3] + 2.f * (p[4] + p[5] + p[6]) + p[7]);
                if (j0 + 2 < 256) atomicAdd(ip + 2, p[7]);
            }
        }
        lds_fence();
        {
            const int qs = lane >> 4, s16 = lane & 15;
            const int cur = (t0 + qs) >> 6;
            int mysel;
            if (cur < 16) {
                mysel = s16;
            } else {
                unsigned e[16];
#pragma unroll
                for (int i = 0; i < 16; ++i) {
                    const int j = s16 + 16 * i;
                    const bool valid = (j >= 1) && (j <= cur - 2);
                    e[i] = valid ? ((__float_as_uint(imp[qs * 260 + j]) & ~255u) | (unsigned)(255 - j)) : 0u;
                }
                mysel = (s16 == 0) ? 0 : ((s16 == 1) ? cur : cur - 1);
                for (int itk = 0; itk < 13; ++itk) {
                    unsigned m = e[0];
#pragma unroll
                    for (int i = 1; i < 16; ++i) m = max(m, e[i]);
                    m = max(m, (unsigned)__shfl_xor((int)m, 1));
                    m = max(m, (unsigned)__shfl_xor((int)m, 2));
                    m = max(m, (unsigned)__shfl_xor((int)m, 4));
                    m = max(m, (unsigned)__shfl_xor((int)m, 8));
#pragma unroll
                    for (int i = 0; i < 16; ++i) e[i] = (e[i] == m) ? 0u : e[i];
                    if (s16 == 3 + itk) mysel = 255 - (int)(m & 255u);
                }
            }
            sel[qs * 16 + s16] = mysel;
        }
        lds_fence();
        const bf16_t* ksb = WSP(bf16_t, O_KSLC) + (size_t)bg * S * 64;
        const bf16_t* vsb = WSP(bf16_t, O_VSLCT) + (size_t)bg * 64 * S;
        for (int qi = 0; qi < 4; ++qi) {
            const int tq = t0 + qi, curq = tq >> 6, nsel = min(16, curq + 1);
            const size_t tokq = (size_t)b * S + tq;
            bf16x8 qs2[2];
#pragma unroll
            for (int ks = 0; ks < 2; ++ks) qs2[ks] = ld8(qn + tokq * 512 + h * 64 + ks * 32 + q4 * 8);
            f32x4 o[4];
#pragma unroll
            for (int dt = 0; dt < 4; ++dt) o[dt] = (f32x4){0.f, 0.f, 0.f, 0.f};
            float ls = 0.f;
            for (int k = 0; k < nsel; ++k) {
                const int j = __builtin_amdgcn_readfirstlane(sel[qi * 16 + k]);
#pragma unroll
                for (int G2 = 0; G2 < 2; ++G2) {
                    const int kb0 = 64 * j + 32 * G2;
                    f32x4 sa = {0.f, 0.f, 0.f, 0.f}, sb = {0.f, 0.f, 0.f, 0.f};
#pragma unroll
                    for (int ks = 0; ks < 2; ++ks) {
                        const bf16x8 ka = ld8(ksb + (size_t)(kb0 + ia) * 64 + ks * 32 + q4 * 8);
                        const bf16x8 kb = ld8(ksb + (size_t)(kb0 + ia + 4) * 64 + ks * 32 + q4 * 8);
                        sa = mfma16(ka, qs2[ks], sa);
                        sb = mfma16(kb, qs2[ks], sb);
                    }
                    float pa[4], pb[4];
#pragma unroll
                    for (int e = 0; e < 4; ++e) {
                        const int key = kb0 + 8 * q4 + e;
                        pa[e] = (key <= tq) ? exp2f(sa[e] - M0) : 0.f;
                        pb[e] = (key + 4 <= tq) ? exp2f(sb[e] - M0) : 0.f;
                        ls += pa[e] + pb[e];
                    }
                    const bf16x8 pf = packp(pa, pb);
#pragma unroll
                    for (int dt = 0; dt < 4; ++dt) {
                        const bf16x8 va = ld8(vsb + (size_t)(dt * 16 + col) * S + kb0 + q4 * 8);
                        o[dt] = mfma16(va, pf, o[dt]);
                    }
                }
            }
            ls += __shfl_xor(ls, 16);
            ls += __shfl_xor(ls, 32);
            const float sc = (qq == qi) ? g1 / ls : 0.f;
#pragma unroll
            for (int dt = 0; dt < 4; ++dt) otot[dt] += o[dt] * sc;
        }
        {
            const bf16_t* kwb = WSP(bf16_t, O_KWIN) + (size_t)bg * S * 64;
            const bf16_t* vwb = WSP(bf16_t, O_VWINT) + (size_t)bg * 64 * S;
            const int lo = max(0, t0 - 511);
            const int G0 = lo >> 5, G1 = (t0 + 3) >> 5;
            f32x4 o[4];
#pragma unroll
            for (int dt = 0; dt < 4; ++dt) o[dt] = (f32x4){0.f, 0.f, 0.f, 0.f};
            float ls = 0.f;
            for (int G = G0; G <= G1; ++G) {
                const int kb0 = 32 * G;
                f32x4 sa = {0.f, 0.f, 0.f, 0.f}, sb = {0.f, 0.f, 0.f, 0.f};
#pragma unroll
                for (int ks = 0; ks < 2; ++ks) {
                    const bf16x8 ka = ld8(kwb + (size_t)(kb0 + ia) * 64 + ks * 32 + q4 * 8);
                    const bf16x8 kb = ld8(kwb + (size_t)(kb0 + ia + 4) * 64 + ks * 32 + q4 * 8);
                    sa = mfma16(ka, qf[ks], sa);
                    sb = mfma16(kb, qf[ks], sb);
                }
                float pa[4], pb[4];
#pragma unroll
                for (int e = 0; e < 4; ++e) {
                    const int key = kb0 + 8 * q4 + e;
                    pa[e] = (key <= t && t - key < 512) ? exp2f(sa[e] - M0) : 0.f;
                    pb[e] = (key + 4 <= t && t - key - 4 < 512) ? exp2f(sb[e] - M0) : 0.f;
                    ls += pa[e] + pb[e];
                }
                const bf16x8 pf = packp(pa, pb);
#pragma unroll
                for (int dt = 0; dt < 4; ++dt) {
                    const bf16x8 va = ld8(vwb + (size_t)(dt * 16 + col) * S + kb0 + q4 * 8);
                    o[dt] = mfma16(va, pf, o[dt]);
                }
            }
            ls += __shfl_xor(ls, 16);
            ls += __shfl_xor(ls, 32);
            const float sc = g2 / ls;
#pragma unroll
            for (int dt = 0; dt < 4; ++dt) otot[dt] += o[dt] * sc;
        }
#pragma unroll
        for (int dt = 0; dt < 4; ++dt) {
            u32x2 w;
            w.x = pk2(otot[dt][0], otot[dt][1]);
            w.y = pk2(otot[dt][2], otot[dt][3]);
            *(u32x2*)(oa + tok * 512 + h * 64 + dt * 16 + 4 * q4) = w;
        }
    }
}

DEV void ph_sgu(const Args& a, int l, unsigned char* smem) {
    const bf16_t* W = WSP(bf16_t, O_SGUW) + (size_t)l * 4 * 128 * 128;
    const bf16_t* vln = WSP(bf16_t, O_VLN);
    const bf16_t* ug = WSP(bf16_t, O_UG);
    const float* sb = a.in[I_SGUB] + l * 512;
    bf16_t* ob = WSP(bf16_t, O_OB);
    for (int it = blockIdx.x; it < 1024; it += gridDim.x) {
        const int ch = it >> 2, g = it & 3, tc0 = ch * 128;
        f32x16 acc[2][1];
        acc_zero(acc);
        gemm_kloop<2, 1, true>(smem, 128, [&](int r, int k0) { return W + (size_t)(g * 128 + r) * 128 + k0; },
                               [&](int kl, int k0) { return vln + (size_t)(tc0 + k0 + kl) * 256 + g * 64; }, acc);
        gemm_epi<2, 1>(acc, [&](int row, int col, float v) {
            const size_t idx = (size_t)(tc0 + row) * 256 + g * 64 + col;
            ob[idx] = (bf16_t)f2bf(bflo((unsigned)ug[idx]) * (v + sb[g * 128 + row]));
        });
    }
}
DEV void ph_pool(const Args& a, int l, unsigned char* smem) {
    const bf16_t* dp = WSP(bf16_t, O_DPOOL);
    const bf16_t* PT = WSP(bf16_t, O_POOLT) + (size_t)l * 4 * 4096;
    const float* sc = a.in[I_POOLS] + l * 256;
    bf16_t* oc = WSP(bf16_t, O_OC);
    for (int it = blockIdx.x; it < 1024; it += gridDim.x) {
        const int mt = it >> 2, g = it & 3, m0 = mt * 128;
        f32x16 acc[2][1];
        acc_zero(acc);
        gemm_kloop<2, 1, false>(smem, 64, [&](int r, int k0) { return dp + (size_t)(m0 + r) * 256 + g * 64 + k0; },
                                [&](int n, int k0) { return PT + (size_t)(g * 64 + n) * 64 + k0; }, acc);
        gemm_epi<2, 1>(acc, [&](int row, int col, float v) {
            oc[(size_t)(m0 + row) * 256 + g * 64 + col] = (bf16_t)f2bf(v * sc[g * 64 + col]);
        });
    }
}
DEV void ph_merge(const Args& a, int l, unsigned char* smem) {
    const bf16_t* xn = WSP(bf16_t, O_XN);
    const bf16_t* WgT = WSP(bf16_t, O_WINT) + (size_t)l * INW * 1024 + (size_t)NZ * 1024;
    bf16_t* mg = WSP(bf16_t, O_MERGED);
    for (int it = blockIdx.x; it < 256 * 16; it += gridDim.x) {
        const int mt = it >> 4, nt = it & 15, m0 = mt * 128, n0 = nt * 64;
        f32x16 accm[2][1];
        acc_zero(accm);
#pragma unroll 1
        for (int i = 0; i < 3; ++i) {
            const bf16_t* oi = (i == 0) ? WSP(bf16_t, O_OA) : (i == 1 ? WSP(bf16_t, O_OB) : WSP(bf16_t, O_OC));
            const int Ki = (i == 0) ? 512 : 256;
            const bf16_t* LT = ((i == 0) ? WSP(bf16_t, O_LAT) + (size_t)l * 1024 * 512
                                         : (i == 1 ? WSP(bf16_t, O_LBT) : WSP(bf16_t, O_LCT)) + (size_t)l * 1024 * 256);
            f32x16 accg[2][1], accl[2][1];
            acc_zero(accg);
            gemm_kloop<2, 1, false>(smem, 1024, [&](int r, int k0) { return xn + (size_t)(m0 + r) * 1024 + k0; },
                                    [&](int n, int k0) { return WgT + (size_t)(i * 1024 + n0 + n) * 1024 + k0; }, accg);
            acc_zero(accl);
            gemm_kloop<2, 1, false>(smem, Ki, [&](int r, int k0) { return oi + (size_t)(m0 + r) * Ki + k0; },
                                    [&](int n, int k0) { return LT + (size_t)(n0 + n) * Ki + k0; }, accl);
#pragma unroll
            for (int mi = 0; mi < 2; ++mi)
#pragma unroll
                for (int rr = 0; rr < 16; ++rr) accm[mi][0][rr] += sigmoidf_(accg[mi][0][rr]) * accl[mi][0][rr];
        }
        gemm_epi<2, 1>(accm, [&](int row, int col, float v) { mg[(size_t)(m0 + row) * 1024 + n0 + col] = (bf16_t)f2bf(v); });
    }
}
DEV void ph_gemm_resid(const Args& a, const bf16_t* A, int K, const bf16_t* Wt, const float* resid, unsigned char* smem) {
    float* out = a.out;
    for (int it = blockIdx.x; it < 256 * 8; it += gridDim.x) {
        const int mt = it >> 3, nt = it & 7, m0 = mt * 128, n0 = nt * 128;
        f32x16 acc[2][2];
        acc_zero(acc);
        gemm_kloop<2, 2, false>(smem, K, [&](int r, int k0) { return A + (size_t)(m0 + r) * K + k0; },
                                [&](int n, int k0) { return Wt + (size_t)(n0 + n) * K + k0; }, acc);
        gemm_epi<2, 2>(acc, [&](int row, int col, float v) {
            const size_t idx = (size_t)(m0 + row) * 1024 + n0 + col;
            out[idx] = resid[idx] + v;
        });
    }
}
DEV void ph_gemm_bf16(const bf16_t* A, const bf16_t* Wt, bf16_t* C, int N, unsigned char* smem) {
    const int ntn = N / 128;
    for (int it = blockIdx.x; it < 256 * ntn; it += gridDim.x) {
        const int mt = it / ntn, nt = it % ntn, m0 = mt * 128, n0 = nt * 128;
        f32x16 acc[2][2];
        acc_zero(acc);
        gemm_kloop<2, 2, false>(smem, 1024, [&](int r, int k0) { return A + (size_t)(m0 + r) * 1024 + k0; },
                                [&](int n, int k0) { return Wt + (size_t)(n0 + n) * 1024 + k0; }, acc);
        gemm_epi<2, 2>(acc, [&](int row, int col, float v) { C[(size_t)(m0 + row) * N + n0 + col] = (bf16_t)f2bf(v); });
    }
}

DEV void ph_xatt(const Args& a, int l) {
    const int tid = threadIdx.x, wave = tid >> 6, lane = tid & 63, col = lane & 15, q4 = lane >> 4;
    const bf16_t* xaq = WSP(bf16_t, O_XAQ);
    bf16_t* xao = WSP(bf16_t, O_XAO);
    const float* qnw = a.in[I_XQN] + l * 128;
    float M0;
    {
        const float gq = wmaxf(fmaxf(fabsf(qnw[lane]), fabsf(qnw[64 + lane])));
        const float* kn = a.in[I_XKN] + l * 128;
        const float gk = wmaxf(fmaxf(fabsf(kn[lane]), fabsf(kn[64 + lane])));
        M0 = 11.313708499f * gq * gk * LOG2E * 1.01f;
    }
    const int ia = 8 * (col >> 2) + (col & 3);
    for (int it = blockIdx.x; it < 2048; it += gridDim.x) {
        const int bh = it & 7, tt = it >> 3, b = bh >> 2, hd = bh & 3;
        const int t = tt * 64 + wave * 16 + col;
        const size_t tok = (size_t)b * S + t;
        bf16x8 qf[4];
        {
            float f[4][8];
            float ss = 0.f;
#pragma unroll
            for (int ks = 0; ks < 4; ++ks) {
                const u32x4 rr = *(const u32x4*)(xaq + tok * 512 + hd * 128 + ks * 32 + q4 * 8);
                unpack8(rr, f[ks]);
#pragma unroll
                for (int e = 0; e < 8; ++e) ss += f[ks][e] * f[ks][e];
            }
            ss += __shfl_xor(ss, 16);
            ss += __shfl_xor(ss, 32);
            const float rs = rsqrtf(ss * (1.f / 128.f) + EPS) * (0.08838834764831845f * LOG2E);
#pragma unroll
            for (int ks = 0; ks < 4; ++ks) {
                const float* gw = qnw + ks * 32 + q4 * 8;
                u32x4 w;
                w.x = pk2(f[ks][0] * rs * gw[0], f[ks][1] * rs * gw[1]);
                w.y = pk2(f[ks][2] * rs * gw[2], f[ks][3] * rs * gw[3]);
                w.z = pk2(f[ks][4] * rs * gw[4], f[ks][5] * rs * gw[5]);
                w.w = pk2(f[ks][6] * rs * gw[6], f[ks][7] * rs * gw[7]);
                qf[ks] = __builtin_bit_cast(bf16x8, w);
            }
        }
        const bf16_t* kb_ = WSP(bf16_t, O_XK) + (size_t)((l * 2 + b) * 4 + hd) * 256 * 128;
        const bf16_t* vb_ = WSP(bf16_t, O_XVT) + (size_t)((l * 2 + b) * 4 + hd) * 128 * 256;
        f32x4 o[8];
#pragma unroll
        for (int dt = 0; dt < 8; ++dt) o[dt] = (f32x4){0.f, 0.f, 0.f, 0.f};
        float ls = 0.f;
        for (int G = 0; G < 8; ++G) {
            const int kb0 = 32 * G;
            f32x4 sa = {0.f, 0.f, 0.f, 0.f}, sb = {0.f, 0.f, 0.f, 0.f};
#pragma unroll
            for (int ks = 0; ks < 4; ++ks) {
                const bf16x8 ka = ld8(kb_ + (size_t)(kb0 + ia) * 128 + ks * 32 + q4 * 8);
                const bf16x8 kb = ld8(kb_ + (size_t)(kb0 + ia + 4) * 128 + ks * 32 + q4 * 8);
                sa = mfma16(ka, qf[ks], sa);
                sb = mfma16(kb, qf[ks], sb);
            }
            float pa[4], pb[4];
#pragma unroll
            for (int e = 0; e < 4; ++e) {
                pa[e] = exp2f(sa[e] - M0);
                pb[e] = exp2f(sb[e] - M0);
                ls += pa[e] + pb[e];
            }
            const bf16x8 pf = packp(pa, pb);
#pragma unroll
            for (int dt = 0; dt < 8; ++dt) {
                const bf16x8 va = ld8(vb_ + (size_t)(dt * 16 + col) * 256 + kb0 + q4 * 8);
                o[dt] = mfma16(va, pf, o[dt]);
            }
        }
        ls += __shfl_xor(ls, 16);
        ls += __shfl_xor(ls, 32);
        const float inv = 1.f / ls;
#pragma unroll
        for (int dt = 0; dt < 8; ++dt) {
            u32x2 w;
            w.x = pk2(o[dt][0] * inv, o[dt][1] * inv);
            w.y = pk2(o[dt][2] * inv, o[dt][3] * inv);
            *(u32x2*)(xao + tok * 512 + hd * 128 + dt * 16 + 4 * q4) = w;
        }
    }
}

DEV void ph_ptop(const Args& a, int l, unsigned char* smem) {
    const bf16_t* pq = WSP(bf16_t, O_PQ);
    const bf16_t* keys = WSP(bf16_t, O_KEYS) + (size_t)l * 2 * 8192;
    unsigned* ptop = WSP(unsigned, O_PTOP);
    float* sc = (float*)smem;
    const int tid = threadIdx.x;
    for (int it = blockIdx.x; it < 512 * 16; it += gridDim.x) {
        const int tt = it >> 4, hh = it & 15, half = hh & 1, t0 = tt * 64;
        f32x16 acc[1][2];
        acc_zero(acc);
        gemm_kloop<1, 2, false>(smem, 64, [&](int r, int k0) { return pq + (size_t)(t0 + r) * 1024 + hh * 64 + k0; },
                                [&](int n, int k0) { return keys + (size_t)(half * 128 + n) * 64 + k0; }, acc);
        __syncthreads();
        gemm_epi<1, 2>(acc, [&](int row, int col, float v) { sc[row * 132 + col] = v; });
        __syncthreads();
        {
            const int row = tid >> 2, sub = tid & 3;
            unsigned e[32];
#pragma unroll
            for (int i = 0; i < 32; ++i) {
                const int k = 4 * i + sub;
                e[i] = (f2sort(sc[row * 132 + k]) & ~127u) | (unsigned)(127 - k);
            }
            u32x4 mine = {0u, 0u, 0u, 0u};
#pragma unroll
            for (int itk = 0; itk < 16; ++itk) {
                unsigned m = e[0];
#pragma unroll
                for (int i = 1; i < 32; ++i) m = max(m, e[i]);
                m = max(m, (unsigned)__shfl_xor((int)m, 1));
                m = max(m, (unsigned)__shfl_xor((int)m, 2));
#pragma unroll
                for (int i = 0; i < 32; ++i) e[i] = (e[i] == m) ? 0u : e[i];
                if ((itk >> 2) == sub) mine[itk & 3] = m;
            }
            *(u32x4*)(ptop + ((size_t)(t0 + row) * 16 + hh) * 16 + 4 * sub) = mine;
        }
    }
}

DEV void ph_pexp(const Args& a) {
    const int wave = threadIdx.x >> 6, lane = threadIdx.x & 63;
    const bf16_t* hf = WSP(bf16_t, O_XN);
    const unsigned* ptop = WSP(unsigned, O_PTOP);
    const bf16_t* U = WSP(bf16_t, O_PU);
    const bf16_t* V = WSP(bf16_t, O_PVB);
    int ci, cj;
    {
        const int L = lane;
        const int i = (L >= 16) + (L >= 24) + (L >= 29) + (L >= 33) + (L >= 36) + (L >= 38) + (L >= 40) + (L >= 42) + (L >= 43) + (L >= 44) +
                      (L >= 45) + (L >= 46) + (L >= 47) + (L >= 48) + (L >= 49);
        const int pre = (i == 0) ? 0 : (i == 1) ? 16 : (i == 2) ? 24 : (i == 3) ? 29 : (i == 4) ? 33 : (i == 5) ? 36 : (i == 6) ? 38 : (i == 7) ? 40 : (34 + i);
        ci = i; cj = L - pre;
    }
    for (int t = blockIdx.x * 4 + wave; t < T; t += gridDim.x * 4) {
        float hv[16];
        {
            const u32x4 r0 = *(const u32x4*)(hf + (size_t)t * 1024 + 8 * lane);
            const u32x4 r1 = *(const u32x4*)(hf + (size_t)t * 1024 + 512 + 8 * lane);
            unpack8(r0, hv); unpack8(r1, hv + 8);
        }
        float outv[16];
#pragma unroll
        for (int i = 0; i < 16; ++i) outv[i] = 0.f;
#pragma unroll 1
        for (int h = 0; h < 8; ++h) {
            unsigned key = 0u;
            if (lane < 32) key = ptop[((size_t)t * 16 + 2 * h) * 16 + lane];
            const float val = sort2f(key & ~127u);
            const int idx = 127 - (int)(key & 127u);
            const float v1 = __shfl(val, ci), v2 = __shfl(val, 16 + cj);
            unsigned ck = (lane < 50) ? ((f2sort(v1 + v2) & ~255u) | (unsigned)(255 - (ci * 16 + cj))) : 0u;
            unsigned mykey = 0u;
#pragma unroll
            for (int itk = 0; itk < 16; ++itk) {
                unsigned m = ck;
#pragma unroll
                for (int o = 32; o >= 1; o >>= 1) m = max(m, (unsigned)__shfl_xor((int)m, o));
                ck = (ck == m) ? 0u : ck;
                if (lane == itk) mykey = m;
            }
            const float cv = sort2f(mykey & ~255u);
            const int p = 255 - (int)(mykey & 255u);
            const int ea = __shfl(idx, (p >> 4) & 15), eb = __shfl(idx, 16 + (p & 15));
            const int eid = ea * 128 + eb;
            const float mx = __shfl(cv, 0);
            float ex = (lane < 16) ? __expf(cv - mx) : 0.f;
            float sm = ex;
            sm += __shfl_xor(sm, 1); sm += __shfl_xor(sm, 2); sm += __shfl_xor(sm, 4); sm += __shfl_xor(sm, 8);
            const float gk = ex / sm;
            float d[16];
#pragma unroll
            for (int kb = 0; kb < 16; kb += 8) {
                u32x4 r0[8], r1[8];
#pragma unroll
                for (int k = 0; k < 8; ++k) {
                    const int ek = __builtin_amdgcn_readlane(eid, kb + k);
                    const bf16_t* ur = U + (size_t)ek * 1024 + 8 * lane;
                    r0[k] = *(const u32x4*)ur;
                    r1[k] = *(const u32x4*)(ur + 512);
                }
#pragma unroll
                for (int k = 0; k < 8; ++k) {
                    float f[16];
                    unpack8(r0[k], f); unpack8(r1[k], f + 8);
                    float s = 0.f;
#pragma unroll
                    for (int i = 0; i < 16; ++i) s += f[i] * hv[i];
                    d[kb + k] = s;
                }
            }
            float d8[8], d4[4], d2[2], d1;
            {
                const bool b5 = (lane & 32) != 0;
#pragma unroll
                for (int i = 0; i < 8; ++i) { const float keep = b5 ? d[i + 8] : d[i], send = b5 ? d[i] : d[i + 8]; d8[i] = keep + __shfl_xor(send, 32); }
                const bool b4 = (lane & 16) != 0;
#pragma unroll
                for (int i = 0; i < 4; ++i) { const float keep = b4 ? d8[i + 4] : d8[i], send = b4 ? d8[i] : d8[i + 4]; d4[i] = keep + __shfl_xor(send, 16); }
                const bool b3 = (lane & 8) != 0;
#pragma unroll
                for (int i = 0; i < 2; ++i) { const float keep = b3 ? d4[i + 2] : d4[i], send = b3 ? d4[i] : d4[i + 2]; d2[i] = keep + __shfl_xor(send, 8); }
                const bool b2 = (lane & 4) != 0;
                { const float keep = b2 ? d2[1] : d2[0], send = b2 ? d2[0] : d2[1]; d1 = keep + __shfl_xor(send, 4); }
                d1 += __shfl_xor(d1, 2);
                d1 += __shfl_xor(d1, 1);
            }
            const float gsh = __shfl(gk, lane >> 2);
            const float coef = gsh * gelu_t(d1);
#pragma unroll
            for (int kb = 0; kb < 16; kb += 8) {
                u32x4 r0[8], r1[8];
#pragma unroll
                for (int k = 0; k < 8; ++k) {
                    const int ek = __builtin_amdgcn_readlane(eid, kb + k);
                    const bf16_t* vr = V + (size_t)ek * 1024 + 8 * lane;
                    r0[k] = *(const u32x4*)vr;
                    r1[k] = *(const u32x4*)(vr + 512);
                }
#pragma unroll
                for (int k = 0; k < 8; ++k) {
                    const float ck2 = __builtin_bit_cast(float, __builtin_amdgcn_readlane(__builtin_bit_cast(int, coef), 4 * (kb + k)));
                    float f[16];
                    unpack8(r0[k], f); unpack8(r1[k], f + 8);
#pragma unroll
                    for (int i = 0; i < 16; ++i) outv[i] += ck2 * f[i];
                }
            }
        }
        float4* orow0 = (float4*)(a.out + (size_t)t * 1024 + 8 * lane);
        float4* orow1 = (float4*)(a.out + (size_t)t * 1024 + 512 + 8 * lane);
        float4 x0 = orow0[0], x1 = orow0[1], x2 = orow1[0], x3 = orow1[1];
        x0.x += outv[0]; x0.y += outv[1]; x0.z += outv[2]; x0.w += outv[3];
        x1.x += outv[4]; x1.y += outv[5]; x1.z += outv[6]; x1.w += outv[7];
        x2.x += outv[8]; x2.y += outv[9]; x2.z += outv[10]; x2.w += outv[11];
        x3.x += outv[12]; x3.y += outv[13]; x3.z += outv[14]; x3.w += outv[15];
        orow0[0] = x0; orow0[1] = x1; orow1[0] = x2; orow1[1] = x3;
    }
}

#define STEP_BEGIN if (step >= a.ph_lo && step < a.ph_hi) {
#define STEP_END } ++step; if (step > a.ph_lo && step < a.ph_hi) cg::this_grid().sync();
template <int l>
DEV void layer_steps(const Args& a, unsigned char* smem, int& step) {
    const float* xcur = (l == 0) ? a.in[I_X] : a.out;
    if (l > 0) {
        STEP_BEGIN
            rmsnorm_rows(a.out, a.in[I_MIXN] + l * 1024, WSP(bf16_t, O_XN), T);
        STEP_END
    }
    STEP_BEGIN
        ph_gemm1(a, l, smem);
        ph_peercvt(a, l);
    STEP_END
    STEP_BEGIN
        ph_post(a, l, smem);
    STEP_END
    STEP_BEGIN
        ph_cmp1(a, l, smem);
    STEP_END
    STEP_BEGIN
        ph_cmp2(a, l);
    STEP_END
    STEP_BEGIN
        ph_nsa(a, l, smem);
        ph_sgu(a, l, smem);
        ph_pool(a, l, smem);
    STEP_END
    STEP_BEGIN
        ph_merge(a, l, smem);
    STEP_END
    STEP_BEGIN
        ph_gemm_resid(a, WSP(bf16_t, O_MERGED), 1024, WSP(bf16_t, O_WOT) + (size_t)l * 1024 * 1024, xcur, smem);
    STEP_END
    STEP_BEGIN
        rmsnorm_rows(a.out, a.in[I_XAN] + l * 1024, WSP(bf16_t, O_XN), T);
    STEP_END
    STEP_BEGIN
        ph_gemm_bf16(WSP(bf16_t, O_XN), WSP(bf16_t, O_XWQT) + (size_t)l * 512 * 1024, WSP(bf16_t, O_XAQ), 512, smem);
    STEP_END
    STEP_BEGIN
        ph_xatt(a, l);
    STEP_END
    STEP_BEGIN
        ph_gemm_resid(a, WSP(bf16_t, O_XAO), 512, WSP(bf16_t, O_XWOT) + (size_t)l * 1024 * 512, a.out, smem);
    STEP_END
    STEP_BEGIN
        rmsnorm_rows(a.out, a.in[I_FFN] + l * 1024, WSP(bf16_t, O_XN), T);
    STEP_END
    STEP_BEGIN
        ph_gemm_bf16(WSP(bf16_t, O_XN), WSP(bf16_t, O_PWQT) + (size_t)l * 1024 * 1024, WSP(bf16_t, O_PQ), 1024, smem);
    STEP_END
    STEP_BEGIN
        ph_ptop(a, l, smem);
    STEP_END
    STEP_BEGIN
        ph_pexp(a);
    STEP_END
}
__global__ void __launch_bounds__(256, 2) fwd_kernel(Args a) {
    __shared__ __attribute__((aligned(16))) unsigned char smem[36864];
    int step = 0;
    STEP_BEGIN
        ph_prep(a, smem);
        ph_mem1(a);
        rmsnorm_rows(a.in[I_X], a.in[I_MIXN], WSP(bf16_t, O_XN), T);
    STEP_END
    STEP_BEGIN
        ph_mem2(a, smem);
    STEP_END
    STEP_BEGIN
        ph_mem3(a);
    STEP_END
    layer_steps<0>(a, smem, step);
    layer_steps<1>(a, smem, step);
}
constexpr int N_STEPS = 3 + 15 + 16;

extern "C" void kernel_launch(void* const* d_in, const int* in_sizes, int n_in, void* d_out, int out_size, void* d_ws, size_t ws_size,
                              hipStream_t stream) {
    static int grid_blocks = 0;
    if (!grid_blocks) {
        int dev = 0, cus = 0, per_cu = 0;
        hipGetDevice(&dev);
        hipDeviceGetAttribute(&cus, hipDeviceAttributeMultiprocessorCount, dev);
        hipOccupancyMaxActiveBlocksPerMultiprocessor(&per_cu, fwd_kernel, 256, 0);
        if (per_cu > 2) per_cu = 2;
        if (per_cu < 1) per_cu = 1;
        grid_blocks = cus * per_cu;
    }
    if (ws_size < WS_NEED) { fprintf(stderr, "workspace too small: %zu < %zu\n", ws_size, (size_t)WS_NEED); return; }
    Args a{};
    for (int i = 0; i < N_IN; ++i) a.in[i] = (const float*)d_in[i];
    a.out = (float*)d_out;
    a.ws = (unsigned char*)d_ws;
#if MEGA
    a.ph_lo = 0; a.ph_hi = N_STEPS;
    void* args[] = {&a};
    hipError_t e = hipLaunchCooperativeKernel((void*)fwd_kernel, dim3(grid_blocks), dim3(256), args, 0, stream);
    if (e != hipSuccess) fprintf(stderr, "cooperative launch failed: %s (grid %d)\n", hipGetErrorString(e), grid_blocks);
#else
    for (int s = 0; s < N_STEPS; ++s) {
        a.ph_lo = s; a.ph_hi = s + 1;
        fwd_kernel<<<dim3(grid_blocks), dim3(256), 0, stream>>>(a);
    }
#endif
}
```

```cpp
#include <hip/hip_runtime.h>
#include <hip/hip_cooperative_groups.h>
#include <stdint.h>
#include <stdio.h>
namespace cg = cooperative_groups;

#ifndef MEGA
#define MEGA 1
#endif

#ifndef REP_ID
#define REP_ID -1
#endif
#define DEV __device__ __forceinline__
typedef unsigned short bf16_t;
typedef __attribute__((ext_vector_type(8))) short bf16x8;
typedef __attribute__((ext_vector_type(2))) float f32x2;
typedef __attribute__((ext_vector_type(4))) float f32x4;
typedef __attribute__((ext_vector_type(16))) float f32x16;
typedef __attribute__((ext_vector_type(4))) unsigned u32x4;
typedef __attribute__((ext_vector_type(2))) unsigned u32x2;

constexpr int NB = 2, S = 16384, T = NB * S, D = 1024, NL = 2;
constexpr int NZ = 2072, INW = 5144;
constexpr int ZKV = 512, ZG = 1280, ZSGU = 1304, ZPOOL = 1816;
constexpr float EPS = 1e-6f;
constexpr float LOG2E = 1.4426950408889634f;

enum { I_X = 0, I_MEM, I_MIXN, I_WIN, I_QN, I_KN, I_PE, I_W1, I_W2, I_LNG, I_LNB, I_SGUW, I_SGUB, I_POOLW, I_POOLS,
       I_LA, I_LB, I_LC, I_WOUT, I_XAN, I_MEMN, I_XWQ, I_XWK, I_XWV, I_XQN, I_XKN, I_XWO, I_FFN, I_PWQ, I_K1, I_K2, I_PU, I_PV, N_IN };

constexpr size_t MiB = 1ull << 20;
constexpr size_t O_WINT = 1 * MiB;
constexpr size_t O_LAT = 22 * MiB;
constexpr size_t O_LBT = 24 * MiB;
constexpr size_t O_LCT = 25 * MiB;
constexpr size_t O_WOT = 26 * MiB;
constexpr size_t O_XWQT = 30 * MiB;
constexpr size_t O_XWKT = 32 * MiB;
constexpr size_t O_XWVT = 34 * MiB;
constexpr size_t O_XWOT = 36 * MiB;
constexpr size_t O_PWQT = 38 * MiB;
constexpr size_t O_W1T = 42 * MiB;
constexpr size_t O_POOLT = 44 * MiB;
constexpr size_t O_SGUW = O_POOLT + 65536;
constexpr size_t O_KEYS = O_SGUW + 262144;
constexpr size_t O_PW1 = O_KEYS + 65536;
constexpr size_t O_MEMH = 45 * MiB;
constexpr size_t O_XKVT = 47 * MiB;
constexpr size_t O_XK = 51 * MiB;
constexpr size_t O_XVT = 52 * MiB;
constexpr size_t O_HID = 53 * MiB;
constexpr size_t O_KC = 55 * MiB;
constexpr size_t O_VCT = O_KC + 524288;
constexpr size_t O_GATE = 56 * MiB;
constexpr size_t O_XN = 60 * MiB;
constexpr size_t O_ZBUF = 124 * MiB;
constexpr size_t O_MERGED = O_ZBUF;
constexpr size_t O_PQ = O_ZBUF + 64 * MiB;
constexpr size_t O_QN = 254 * MiB;
constexpr size_t O_XAQ = O_QN;
constexpr size_t O_KSLC = 286 * MiB;
constexpr size_t O_KWIN = 294 * MiB;
constexpr size_t O_VSLCT = 302 * MiB;
constexpr size_t O_VWINT = 310 * MiB;
constexpr size_t O_UG = 318 * MiB;
constexpr size_t O_VLN = 334 * MiB;
constexpr size_t O_DPOOL = 350 * MiB;
constexpr size_t O_PTOP = O_UG;
constexpr size_t O_OA = 366 * MiB;
constexpr size_t O_XAO = O_OA;
constexpr size_t O_OB = 398 * MiB;
constexpr size_t O_OC = 414 * MiB;
constexpr size_t O_PU = 430 * MiB;
constexpr size_t O_PVB = 446 * MiB;
constexpr size_t O_PSC = 462 * MiB;
constexpr size_t O_RSS = 463 * MiB;
constexpr size_t WS_NEED = 464 * MiB;

struct Args {
    const float* in[N_IN];
    float* out;
    unsigned char* ws;
    int ph_lo, ph_hi;
};

DEV float bflo(unsigned w) { return __uint_as_float(w << 16); }
DEV float bfhi(unsigned w) { return __uint_as_float(w & 0xffff0000u); }
DEV unsigned pk2(float lo, float hi);
DEV unsigned f2bf(float f) { return pk2(f, 0.f) & 0xffffu; }
typedef __attribute__((ext_vector_type(2))) __bf16 bf16x2v;
DEV unsigned pk2(float lo, float hi) { f32x2 v = {lo, hi}; return __builtin_bit_cast(unsigned, __builtin_convertvector(v, bf16x2v)); }
template <int CTRL> DEV int dpp_i(int v) { return __builtin_amdgcn_update_dpp(v, v, CTRL, 0xF, 0xF, false); }
template <int CTRL> DEV float dpp_f(float v) { return __builtin_bit_cast(float, dpp_i<CTRL>(__builtin_bit_cast(int, v))); }
DEV float sum4(float v) { v += dpp_f<0xB1>(v); v += dpp_f<0x4E>(v); return v; }
DEV float sum8(float v) { v = sum4(v); v += dpp_f<0x141>(v); return v; }
DEV float sum16(float v) { v = sum8(v); v += dpp_f<0x140>(v); return v; }
DEV unsigned max4u(unsigned v) { v = max(v, (unsigned)dpp_i<0xB1>((int)v)); v = max(v, (unsigned)dpp_i<0x4E>((int)v)); return v; }
DEV unsigned max16u(unsigned v) { v = max4u(v); v = max(v, (unsigned)dpp_i<0x141>((int)v)); v = max(v, (unsigned)dpp_i<0x140>((int)v)); return v; }
DEV float wsum(float v) {
#pragma unroll
    for (int o = 32; o >= 1; o >>= 1) v += __shfl_xor(v, o);
    return v;
}
DEV float wmaxf(float v) {
#pragma unroll
    for (int o = 32; o >= 1; o >>= 1) v = fmaxf(v, __shfl_xor(v, o));
    return v;
}
DEV float gelu_t(float x) {
    float u = 0.7978845608028654f * (x + 0.044715f * x * x * x);
    return x / (1.f + __expf(-2.f * u));
}
DEV float fexp2(float x) { return __builtin_amdgcn_exp2f(x); }
DEV float sigmoidf_(float x) { return 1.f / (1.f + __expf(-x)); }
DEV unsigned f2sort(float f) { unsigned u = __float_as_uint(f); return (u & 0x80000000u) ? ~u : (u | 0x80000000u); }
DEV float sort2f(unsigned s) { unsigned u = (s & 0x80000000u) ? (s & 0x7fffffffu) : ~s; return __uint_as_float(u); }
DEV void unpack8(u32x4 r, float* f) {
    f[0] = bflo(r.x); f[1] = bfhi(r.x); f[2] = bflo(r.y); f[3] = bfhi(r.y);
    f[4] = bflo(r.z); f[5] = bfhi(r.z); f[6] = bflo(r.w); f[7] = bfhi(r.w);
}
DEV f32x4 mfma16(bf16x8 a, bf16x8 b, f32x4 c) { return __builtin_amdgcn_mfma_f32_16x16x32_bf16(a, b, c, 0, 0, 0); }
DEV f32x16 mfma32(bf16x8 a, bf16x8 b, f32x16 c) { return __builtin_amdgcn_mfma_f32_32x32x16_bf16(a, b, c, 0, 0, 0); }
DEV bf16x8 ld8(const bf16_t* p) { return *(const bf16x8*)p; }
DEV void lds_fence() { asm volatile("s_waitcnt lgkmcnt(0)" ::: "memory"); }

DEV void transpose_cvt(unsigned char* smem, const float* __restrict__ W, int K, int N, bf16_t* __restrict__ WT, int ldt, const float* __restrict__ gk = nullptr) {
    float* tile = (float*)smem;
    const int tk = (K + 63) / 64, tn = (N + 63) / 64;
    for (int it = blockIdx.x; it < tk * tn; it += gridDim.x) {
        const int k0 = (it / tn) * 64, n0 = (it % tn) * 64;
        __syncthreads();
        for (int idx = threadIdx.x; idx < 4096; idx += 256) {
            const int k = idx >> 6, n = idx & 63;
            float v = 0.f;
            if (k0 + k < K && n0 + n < N) v = W[(size_t)(k0 + k) * N + n0 + n] * (gk ? gk[k0 + k] : 1.f);
            tile[k * 65 + n] = v;
        }
        __syncthreads();
        for (int idx = threadIdx.x; idx < 4096; idx += 256) {
            const int n = idx >> 6, k = idx & 63;
            if (k0 + k < K && n0 + n < N) WT[(size_t)(n0 + n) * ldt + k0 + k] = (bf16_t)f2bf(tile[k * 65 + n]);
        }
    }
}

DEV void rmsnorm_rows(const float* __restrict__ X, const float* __restrict__ g, bf16_t* __restrict__ Y, int rows) {
    const int wave = threadIdx.x >> 6, lane = threadIdx.x & 63;
    for (int r = blockIdx.x * 4 + wave; r < rows; r += gridDim.x * 4) {
        const float4* xr = (const float4*)(X + (size_t)r * 1024);
        float4 v[4];
        float ss = 0.f;
#pragma unroll
        for (int i = 0; i < 4; ++i) { v[i] = xr[lane + 64 * i]; ss += v[i].x * v[i].x + v[i].y * v[i].y + v[i].z * v[i].z + v[i].w * v[i].w; }
        ss = wsum(ss);
        const float rs = rsqrtf(ss * (1.f / 1024.f) + EPS);
#pragma unroll
        for (int i = 0; i < 4; ++i) {
            const float4 gg = ((const float4*)g)[lane + 64 * i];
            u32x2 o;
            o.x = pk2(v[i].x * rs * gg.x, v[i].y * rs * gg.y);
            o.y = pk2(v[i].z * rs * gg.z, v[i].w * rs * gg.w);
            *(u32x2*)(Y + (size_t)r * 1024 + (lane + 64 * i) * 4) = o;
        }
    }
}

DEV void x_to_bf16_rss(const float* __restrict__ X, bf16_t* __restrict__ Y, float* __restrict__ rsp, int rows) {
    const int wave = threadIdx.x >> 6, lane = threadIdx.x & 63;
    for (int r = blockIdx.x * 4 + wave; r < rows; r += gridDim.x * 4) {
        const float4* xr = (const float4*)(X + (size_t)r * 1024);
        float4 v[4];
        float ss = 0.f;
#pragma unroll
        for (int i = 0; i < 4; ++i) { v[i] = xr[lane + 64 * i]; ss += v[i].x * v[i].x + v[i].y * v[i].y + v[i].z * v[i].z + v[i].w * v[i].w; }
        ss = wsum(ss);
#pragma unroll
        for (int i = 0; i < 4; ++i) {
            u32x2 o;
            o.x = pk2(v[i].x, v[i].y);
            o.y = pk2(v[i].z, v[i].w);
            *(u32x2*)(Y + (size_t)r * 1024 + (lane + 64 * i) * 4) = o;
        }
        if (lane < 8) rsp[(size_t)lane * T + r] = ss * 0.125f;
    }
}

template <int MI, int NI, bool BKN, class AF, class BF>
DEV void gemm_kloop_rs(unsigned char* smem, int K, AF arow, BF brow, f32x16 (&acc)[MI][NI]) {
    constexpr int BM = 64 * MI, BN = 64 * NI;
    constexpr int LA = BM / 32, LB = BN / 32;
    bf16_t* As = (bf16_t*)smem;
    bf16_t* Bs = As + BM * 72;
    const int tid = threadIdx.x, lane = tid & 63, wave = tid >> 6, wm = wave >> 1, wn = wave & 1;
    const int lr = tid >> 3, ls = (tid & 7) * 8;
    u32x4 ra[LA], rb[LB];
#pragma unroll
    for (int i = 0; i < LA; ++i) ra[i] = *(const u32x4*)(arow(lr + 32 * i, 0) + ls);
#pragma unroll
    for (int i = 0; i < LB; ++i) rb[i] = *(const u32x4*)(brow(lr + 32 * i, 0) + ls);
    for (int k0 = 0; k0 < K; k0 += 64) {
        __syncthreads();
#pragma unroll
        for (int i = 0; i < LA; ++i) *(u32x4*)(As + (lr + 32 * i) * 72 + ls) = ra[i];
        if (!BKN) {
#pragma unroll
            for (int i = 0; i < LB; ++i) *(u32x4*)(Bs + (lr + 32 * i) * 72 + ls) = rb[i];
        } else {
#pragma unroll
            for (int i = 0; i < LB; ++i) {
                const int kl = lr + 32 * i;
                const unsigned w[4] = {rb[i].x, rb[i].y, rb[i].z, rb[i].w};
#pragma unroll
                for (int e = 0; e < 4; ++e) {
                    Bs[(ls + 2 * e) * 72 + kl] = (bf16_t)(w[e] & 0xffffu);
                    Bs[(ls + 2 * e + 1) * 72 + kl] = (bf16_t)(w[e] >> 16);
                }
            }
        }
        __syncthreads();
        if (k0 + 64 < K) {
#pragma unroll
            for (int i = 0; i < LA; ++i) ra[i] = *(const u32x4*)(arow(lr + 32 * i, k0 + 64) + ls);
#pragma unroll
            for (int i = 0; i < LB; ++i) rb[i] = *(const u32x4*)(brow(lr + 32 * i, k0 + 64) + ls);
        }
#pragma unroll
        for (int kk = 0; kk < 4; ++kk) {
            bf16x8 af[MI], bfr[NI];
#pragma unroll
            for (int mi = 0; mi < MI; ++mi) af[mi] = ld8(As + (wm * 32 * MI + mi * 32 + (lane & 31)) * 72 + kk * 16 + (lane >> 5) * 8);
#pragma unroll
            for (int ni = 0; ni < NI; ++ni) bfr[ni] = ld8(Bs + (wn * 32 * NI + ni * 32 + (lane & 31)) * 72 + kk * 16 + (lane >> 5) * 8);
#pragma unroll
            for (int mi = 0; mi < MI; ++mi)
#pragma unroll
                for (int ni = 0; ni < NI; ++ni) acc[mi][ni] = mfma32(af[mi], bfr[ni], acc[mi][ni]);
        }
    }
}
template <int MI, int NI>
DEV void acc_zero_rs(f32x16 (&acc)[MI][NI]) {
#pragma unroll
    for (int mi = 0; mi < MI; ++mi)
#pragma unroll
        for (int ni = 0; ni < NI; ++ni)
#pragma unroll
            for (int r = 0; r < 16; ++r) acc[mi][ni][r] = 0.f;
}
template <int MI, int NI, class EF>
DEV void gemm_epi_rs(f32x16 (&acc)[MI][NI], EF epi) {
    const int lane = threadIdx.x & 63, wave = threadIdx.x >> 6, wm = wave >> 1, wn = wave & 1;
#pragma unroll
    for (int mi = 0; mi < MI; ++mi)
#pragma unroll
        for (int ni = 0; ni < NI; ++ni)
#pragma unroll
            for (int r = 0; r < 16; ++r) {
                const int row = wm * 32 * MI + mi * 32 + (r & 3) + 8 * (r >> 2) + 4 * (lane >> 5);
                const int col = wn * 32 * NI + ni * 32 + (lane & 31);
                epi(row, col, acc[mi][ni][r]);
            }
}


#define LAS_ __attribute__((address_space(3)))
#define GAS_ __attribute__((address_space(1)))
DEV void glds16(const void* g, void* l) { __builtin_amdgcn_global_load_lds((const GAS_ unsigned*)g, (LAS_ unsigned*)l, 16, 0, 0); }
DEV void stage_rc(int b, int& R, int& C) {
    const int st = b >> 10, sb = b & 1023, swz = sb ^ (((sb >> 9) & 1) << 5);
    R = (st >> 1) * 16 + (swz >> 6);
    C = (st & 1) * 32 + ((swz & 63) >> 1);
}
template <int FM, int FN, class AF, class BF>
DEV void gemm_kloop(unsigned char* smem, int K, AF arow, BF brow, f32x4 (&acc)[FM][FN]) {
    constexpr int BM = 32 * FM, BN = 32 * FN, ABYTES = BM * 128, BBYTES = BN * 128, BUF = ABYTES + BBYTES;
    int tid = threadIdx.x;
    asm volatile("" : "+v"(tid));
    const int lane = tid & 63, wave = tid >> 6, wm = wave >> 1, wn = wave & 1, fr = lane & 15, fq = lane >> 4;
    const int lofs = (fr * 64 + fq * 16) ^ ((fr >> 3) << 5);
    auto stage = [&](int buf, int k0) {
        unsigned char* As = smem + buf * BUF;
        unsigned char* Bs = As + ABYTES;
#pragma unroll
        for (int i = 0; i < BM / 32; ++i) { const int b = tid * 16 + i * 4096; int R, C; stage_rc(b, R, C); glds16(arow(R, k0) + C, As + b); }
#pragma unroll
        for (int i = 0; i < BN / 32; ++i) { const int b = tid * 16 + i * 4096; int R, C; stage_rc(b, R, C); glds16(brow(R, k0) + C, Bs + b); }
    };
    __syncthreads();
    stage(0, 0);
    asm volatile("s_waitcnt vmcnt(0)" ::: "memory");
    __syncthreads();
    const int nt = K >> 6;
    for (int t = 0; t < nt; ++t) {
        if (t + 1 < nt) stage((t + 1) & 1, (t + 1) * 64);
        const unsigned char* As = smem + (t & 1) * BUF + (wm * FM) * 2048 + lofs;
        const unsigned char* Bs = smem + (t & 1) * BUF + ABYTES + (wn * FN) * 2048 + lofs;
#pragma unroll
        for (int k = 0; k < 2; ++k) {
            bf16x8 af[FM], bfr[FN];
#pragma unroll
            for (int m = 0; m < FM; ++m) af[m] = *(const bf16x8*)(As + (m * 2 + k) * 1024);
#pragma unroll
            for (int n = 0; n < FN; ++n) bfr[n] = *(const bf16x8*)(Bs + (n * 2 + k) * 1024);
#pragma unroll
            for (int m = 0; m < FM; ++m)
#pragma unroll
                for (int n = 0; n < FN; ++n) acc[m][n] = mfma16(af[m], bfr[n], acc[m][n]);
        }
        __builtin_amdgcn_sched_barrier(0);
        asm volatile("s_waitcnt vmcnt(0)" ::: "memory");
        __syncthreads();
    }
}
template <int FM, int FN>
DEV void acc_zero(f32x4 (&acc)[FM][FN]) {
#pragma unroll
    for (int m = 0; m < FM; ++m)
#pragma unroll
        for (int n = 0; n < FN; ++n) acc[m][n] = (f32x4){0.f, 0.f, 0.f, 0.f};
}
template <int FM, int FN, class EF>
DEV void gemm_epi(f32x4 (&acc)[FM][FN], EF epi) {
    const int lane = threadIdx.x & 63, wave = threadIdx.x >> 6, wm = wave >> 1, wn = wave & 1, fr = lane & 15, fq = lane >> 4;
#pragma unroll
    for (int m = 0; m < FM; ++m)
#pragma unroll
        for (int n = 0; n < FN; ++n)
#pragma unroll
            for (int j = 0; j < 4; ++j) epi(wm * 16 * FM + m * 16 + fq * 4 + j, wn * 16 * FN + n * 16 + fr, acc[m][n][j]);
}

struct TileIter {
    int lt, lstep, ltot, x, nt_n; bool xm;
    DEV TileIter(int n_mt, int n_nt) {
        xm = ((gridDim.x & 7) == 0) && ((n_mt & 7) == 0);
        nt_n = n_nt;
        if (xm) { x = blockIdx.x & 7; lt = blockIdx.x >> 3; lstep = gridDim.x >> 3; ltot = (n_mt >> 3) * n_nt; }
        else { x = 0; lt = blockIdx.x; lstep = gridDim.x; ltot = n_mt * n_nt; }
    }
    DEV bool valid() const { return lt < ltot; }
    DEV void next() { lt += lstep; }
    DEV int mt() const { return xm ? ((lt / nt_n) * 8 + x) : (lt / nt_n); }
    DEV int nt() const { return lt % nt_n; }
};

template <int FM, int FN, class AF, class BF>
DEV void gemm_kloop32(unsigned char* smem, int K, AF arow, BF brow, f32x4 (&acc)[FM][FN]) {
    constexpr int BM = 32 * FM, BN = 32 * FN, ABYTES = BM * 64, BBYTES = BN * 64, BUF = ABYTES + BBYTES;
    static_assert(ABYTES % 4096 == 0 && BBYTES % 1024 == 0, "A rows must be a multiple of 64, B rows a multiple of 16");
    int tid = threadIdx.x;
    asm volatile("" : "+v"(tid));
    const int lane = tid & 63, wave = tid >> 6, wm = wave >> 1, wn = wave & 1, fr = lane & 15, fq = lane >> 4;
    const int lofs = (fr * 64 + fq * 16) ^ ((fr >> 3) << 5);
    auto stage = [&](int buf, int k0) {
        unsigned char* As = smem + buf * BUF;
        unsigned char* Bs = As + ABYTES;
#pragma unroll
        for (int i = 0; i < ABYTES / 4096; ++i) {
            const int b = tid * 16 + i * 4096, sb = b & 1023, swz = sb ^ (((sb >> 9) & 1) << 5);
            glds16(arow((b >> 10) * 16 + (swz >> 6), k0) + ((swz & 63) >> 1), As + b);
        }
#pragma unroll
        for (int i = 0; i < (BBYTES + 4095) / 4096; ++i) {
            const int b = tid * 16 + i * 4096, sb = b & 1023, swz = sb ^ (((sb >> 9) & 1) << 5);
            if ((BBYTES % 4096) == 0 || b < BBYTES)
                glds16(brow((b >> 10) * 16 + (swz >> 6), k0) + ((swz & 63) >> 1), Bs + b);
        }
    };
    __syncthreads();
    stage(0, 0);
    asm volatile("s_waitcnt vmcnt(0)" ::: "memory");
    __syncthreads();
    const int nt = K >> 5;
    for (int t = 0; t < nt; ++t) {
        if (t + 1 < nt) stage((t + 1) & 1, (t + 1) * 32);
        const unsigned char* As = smem + (t & 1) * BUF + (wm * FM) * 1024 + lofs;
        const unsigned char* Bs = smem + (t & 1) * BUF + ABYTES + (wn * FN) * 1024 + lofs;
        bf16x8 af[FM];
#pragma unroll
        for (int m = 0; m < FM; ++m) af[m] = *(const bf16x8*)(As + m * 1024);
        constexpr int NH = (FN % 3 == 0 && FN > 6) ? 3 : ((FN > 4) ? 2 : 1), FNH = FN / NH;
        static_assert(FNH * NH == FN, "FN must split evenly");
#pragma unroll
        for (int hh = 0; hh < NH; ++hh) {
            bf16x8 bfr[FNH];
#pragma unroll
            for (int n = 0; n < FNH; ++n) bfr[n] = *(const bf16x8*)(Bs + (hh * FNH + n) * 1024);
#pragma unroll
            for (int m = 0; m < FM; ++m)
#pragma unroll
                for (int n = 0; n < FNH; ++n) acc[m][hh * FNH + n] = mfma16(af[m], bfr[n], acc[m][hh * FNH + n]);
        }
        __builtin_amdgcn_sched_barrier(0);
        asm volatile("s_waitcnt vmcnt(0)" ::: "memory");
        __syncthreads();
    }
}

template <int FM, int FN, int G0, int G1, int G2, class AF, class BF>
DEV void gemm_kloop_seg3(unsigned char* smem, AF arow, BF brow, f32x4 (&acc0)[FM][FN], f32x4 (&acc1)[FM][FN], f32x4 (&acc2)[FM][FN]) {
    constexpr int BM = 32 * FM, BN = 32 * FN, ABYTES = BM * 128, BBYTES = BN * 128, BUF = ABYTES + BBYTES, NT = G0 + G1 + G2;
    int tid = threadIdx.x;
    asm volatile("" : "+v"(tid));
    const int lane = tid & 63, wave = tid >> 6, wm = wave >> 1, wn = wave & 1, fr = lane & 15, fq = lane >> 4;
    const int lofs = (fr * 64 + fq * 16) ^ ((fr >> 3) << 5);
    auto stage = [&](int buf, int g) {
        unsigned char* As = smem + buf * BUF;
        unsigned char* Bs = As + ABYTES;
#pragma unroll
        for (int i = 0; i < BM / 32; ++i) { const int b = tid * 16 + i * 4096; int R, C; stage_rc(b, R, C); glds16(arow(R, g) + C, As + b); }
#pragma unroll
        for (int i = 0; i < BN / 32; ++i) { const int b = tid * 16 + i * 4096; int R, C; stage_rc(b, R, C); glds16(brow(R, g) + C, Bs + b); }
    };
    __syncthreads();
    stage(0, 0);
    asm volatile("s_waitcnt vmcnt(0)" ::: "memory");
    __syncthreads();
    for (int t = 0; t < NT; ++t) {
        if (t + 1 < NT) stage((t + 1) & 1, t + 1);
        const unsigned char* As = smem + (t & 1) * BUF + (wm * FM) * 2048 + lofs;
        const unsigned char* Bs = smem + (t & 1) * BUF + ABYTES + (wn * FN) * 2048 + lofs;
#pragma unroll
        for (int k = 0; k < 2; ++k) {
            bf16x8 af[FM], bfr[FN];
#pragma unroll
            for (int m = 0; m < FM; ++m) af[m] = *(const bf16x8*)(As + (m * 2 + k) * 1024);
#pragma unroll
            for (int n = 0; n < FN; ++n) bfr[n] = *(const bf16x8*)(Bs + (n * 2 + k) * 1024);
            if (t < G0) {
#pragma unroll
                for (int m = 0; m < FM; ++m)
#pragma unroll
                    for (int n = 0; n < FN; ++n) acc0[m][n] = mfma16(af[m], bfr[n], acc0[m][n]);
            } else if (t < G0 + G1) {
#pragma unroll
                for (int m = 0; m < FM; ++m)
#pragma unroll
                    for (int n = 0; n < FN; ++n) acc1[m][n] = mfma16(af[m], bfr[n], acc1[m][n]);
            } else {
#pragma unroll
                for (int m = 0; m < FM; ++m)
#pragma unroll
                    for (int n = 0; n < FN; ++n) acc2[m][n] = mfma16(af[m], bfr[n], acc2[m][n]);
            }
        }
        __builtin_amdgcn_sched_barrier(0);
        asm volatile("s_waitcnt vmcnt(0)" ::: "memory");
        __syncthreads();
    }
}

#define LAS __attribute__((address_space(3)))
#define XB_TMO      128
#define XB_XCNT(j)  (256  + 64 * (j))
#define XB_XSUB(j)  (1280 + 64 * (j))
#define XB_XGEN(j)  (2304 + 64 * (j))
#define XB_TOP      3328
#define XB_TOPGEN   3392
#define XCD_BAR_WORDS 3456
#define XB_SPIN_CAP (1u << 25)
DEV unsigned xb_ld(unsigned* p) { return __hip_atomic_load(p, __ATOMIC_RELAXED, __HIP_MEMORY_SCOPE_AGENT); }
DEV unsigned xb_add(unsigned* p, unsigned v) { return __hip_atomic_fetch_add(p, v, __ATOMIC_RELAXED, __HIP_MEMORY_SCOPE_AGENT); }
DEV unsigned xb_xcc_id() { return (unsigned)__builtin_amdgcn_s_getreg((3 << 11) | 20) & 0xFu; }
#define XB_SPIN(cond, bar) do { unsigned _sp = 0; while (cond) { __builtin_amdgcn_s_sleep(1); \
    if ((++_sp & 255u) == 0u) { if (xb_ld(&(bar)[XB_TMO])) break; if (_sp > XB_SPIN_CAP) { atomicAdd(&(bar)[XB_TMO], 1u); break; } } } } while (0)
struct XcdBarrier { unsigned* bar; unsigned x; volatile LAS unsigned* st; };
DEV XcdBarrier xcd_barrier_post(unsigned* bar, volatile LAS unsigned* st) {
    XcdBarrier b; b.bar = bar; b.x = xb_xcc_id(); b.st = st;
    if (threadIdx.x == 0) (void)xb_add(&bar[XB_XCNT(b.x)], 1u);
    return b;
}
DEV void xcd_barrier_complete(unsigned* bar, unsigned x, unsigned& nloc, unsigned& nx) {
    const unsigned G = gridDim.x * gridDim.y * gridDim.z;
    unsigned sum, cnt, mine, sp = 0u;
    for (;;) {
        sum = 0u; cnt = 0u; mine = 0u;
#pragma unroll
        for (unsigned j = 0; j < 16; ++j) { const unsigned c = xb_ld(&bar[XB_XCNT(j)]); sum += c; cnt += (c > 0u) ? 1u : 0u; mine = (j == x) ? c : mine; }
        if (sum == G) break;
        __builtin_amdgcn_s_sleep(1);
        if ((++sp & 255u) == 0u) { if (xb_ld(&bar[XB_TMO])) break; if (sp > XB_SPIN_CAP) { atomicAdd(&bar[XB_TMO], 1u); break; } }
    }
    nloc = mine > 0u ? mine : 1u; nx = cnt > 0u ? cnt : 1u;
}
DEV void xcd_barrier(unsigned* bar_, unsigned bx_, volatile LAS unsigned* st_) {
    XcdBarrier b; b.bar = bar_; b.x = bx_; b.st = st_;
    asm volatile("s_waitcnt vmcnt(0)" ::: "memory");
    __syncthreads();
    if (threadIdx.x == 0) {
        unsigned* bar = b.bar;
        __builtin_amdgcn_s_waitcnt(0);
        unsigned nloc = b.st[0], nx = b.st[1];
        if (nloc == 0u) { xcd_barrier_complete(bar, b.x, nloc, nx); b.st[0] = nloc; b.st[1] = nx; }
        const unsigned old = xb_add(&bar[XB_XSUB(b.x)], 1u);
        const unsigned gen = old / nloc;
        if (old + 1u == (gen + 1u) * nloc) {
            __builtin_amdgcn_fence(__ATOMIC_RELEASE, "agent");
            asm volatile("s_waitcnt vmcnt(0)" ::: "memory");
            const unsigned og = xb_add(&bar[XB_TOP], 1u);
            const unsigned tg = og / nx;
            if (og + 1u == (tg + 1u) * nx) xb_add(&bar[XB_TOPGEN], 1u);
            else XB_SPIN(xb_ld(&bar[XB_TOPGEN]) == tg, bar);
            __builtin_amdgcn_fence(__ATOMIC_ACQUIRE, "agent");
            xb_add(&bar[XB_XGEN(b.x)], 1u);
            asm volatile("s_waitcnt vmcnt(0)" ::: "memory");
        } else {
            XB_SPIN(xb_ld(&bar[XB_XGEN(b.x)]) == gen, bar);
            __builtin_amdgcn_fence(__ATOMIC_ACQUIRE, "agent");
            asm volatile("s_waitcnt vmcnt(0)" ::: "memory");
        }
    }
    __syncthreads();
}

#define WSP(T_, off) ((T_*)(a.ws + (off)))
DEV float row_rstd(const float* rsp, int row) {
    float s = 0.f;
#pragma unroll
    for (int i = 0; i < 8; ++i) s += rsp[(size_t)i * T + row];
    return rsqrtf(s * (1.f / 1024.f) + EPS);
}

DEV void ph_prep(const Args& a, unsigned char* smem) {
    for (int l = 0; l < NL; ++l) {
        transpose_cvt(smem, a.in[I_WIN] + (size_t)l * 1024 * INW, 1024, INW, WSP(bf16_t, O_WINT) + (size_t)l * INW * 1024, 1024, a.in[I_MIXN] + l * 1024);
        transpose_cvt(smem, a.in[I_LA] + (size_t)l * 512 * 1024, 512, 1024, WSP(bf16_t, O_LAT) + (size_t)l * 1024 * 1024, 1024);
        transpose_cvt(smem, a.in[I_LB] + (size_t)l * 256 * 1024, 256, 1024, WSP(bf16_t, O_LAT) + (size_t)l * 1024 * 1024 + 512, 1024);
        transpose_cvt(smem, a.in[I_LC] + (size_t)l * 256 * 1024, 256, 1024, WSP(bf16_t, O_LAT) + (size_t)l * 1024 * 1024 + 768, 1024);
        transpose_cvt(smem, a.in[I_WOUT] + (size_t)l * 1024 * 1024, 1024, 1024, WSP(bf16_t, O_WOT) + (size_t)l * 1024 * 1024, 1024);
        transpose_cvt(smem, a.in[I_XWQ] + (size_t)l * 1024 * 512, 1024, 512, WSP(bf16_t, O_XWQT) + (size_t)l * 512 * 1024, 1024, a.in[I_XAN] + l * 1024);
        transpose_cvt(smem, a.in[I_XWK] + (size_t)l * 1024 * 512, 1024, 512, WSP(bf16_t, O_XWKT) + (size_t)l * 512 * 1024, 1024);
        transpose_cvt(smem, a.in[I_XWV] + (size_t)l * 1024 * 512, 1024, 512, WSP(bf16_t, O_XWVT) + (size_t)l * 512 * 1024, 1024);
        transpose_cvt(smem, a.in[I_XWO] + (size_t)l * 512 * 1024, 512, 1024, WSP(bf16_t, O_XWOT) + (size_t)l * 1024 * 512, 512);
        transpose_cvt(smem, a.in[I_PWQ] + (size_t)l * 1024 * 1024, 1024, 1024, WSP(bf16_t, O_PWQT) + (size_t)l * 1024 * 1024, 1024, a.in[I_FFN] + l * 1024);
        for (int c = 0; c < 2; ++c)
            transpose_cvt(smem, a.in[I_W1] + (size_t)(l * 2 + c) * 2048 * 128, 2048, 128, WSP(bf16_t, O_W1T) + (size_t)(l * 2 + c) * 128 * 2048, 2048);
        for (int g = 0; g < 4; ++g)
            transpose_cvt(smem, a.in[I_POOLW] + (size_t)(l * 4 + g) * 4096, 64, 64, WSP(bf16_t, O_POOLT) + (size_t)(l * 4 + g) * 4096, 64);
    }
    const int gtid = blockIdx.x * 256 + threadIdx.x, gsz = gridDim.x * 256;
    {
        bf16_t* o = WSP(bf16_t, O_SGUW);
        const float* w = a.in[I_SGUW];
        for (int idx = gtid; idx < NL * 4 * 128 * 128; idx += gsz) {
            const int t = (idx >> 7) & 127, s = idx & 127;
            o[idx] = (bf16_t)f2bf(s <= t ? w[idx] : 0.f);
        }
    }
    {
        bf16_t* o = WSP(bf16_t, O_KEYS);
        for (int idx = gtid; idx < NL * 2 * 8192; idx += gsz) {
            const int l = idx >> 14, half = (idx >> 13) & 1, rem = idx & 8191;
            o[idx] = (bf16_t)f2bf((half ? a.in[I_K2] : a.in[I_K1])[l * 8192 + rem]);
        }
    }
    {
        float* o = WSP(float, O_PW1);
        for (int idx = gtid; idx < NL * 2 * 128; idx += gsz) {
            const int lc = idx >> 7, e = idx & 127;
            const float* pe = a.in[I_PE] + (size_t)lc * 2048;
            const float* w1 = a.in[I_W1] + (size_t)lc * 2048 * 128 + e;
            float s = 0.f;
            for (int k = 0; k < 2048; ++k) s += pe[k] * w1[(size_t)k * 128];
            o[idx] = s;
        }
    }
}

DEV void ph_peercvt(const Args& a, int l, int k_lo = 0, int k_hi = 1 << 20) {
    const int wave = threadIdx.x >> 6, lane = threadIdx.x & 63;
    for (int kk = k_lo, rw0 = (blockIdx.x * 4 + wave) * 4 + k_lo * (int)gridDim.x * 16; kk < k_hi && rw0 < 2 * 16384; ++kk, rw0 += gridDim.x * 16) {
        const int tb = rw0 >> 14, e0 = rw0 & 16383;
        const float4* src = (const float4*)((tb ? a.in[I_PV] : a.in[I_PU]) + ((size_t)l * 16384 + e0) * 1024);
        float4 v[4][4];
#pragma unroll
        for (int r = 0; r < 4; ++r)
#pragma unroll
            for (int i = 0; i < 4; ++i) v[r][i] = src[r * 256 + lane + 64 * i];
        if (tb == 0) {
#pragma unroll
            for (int i = 0; i < 4; ++i) {
                const float4 g4 = ((const float4*)(a.in[I_FFN] + l * 1024))[lane + 64 * i];
#pragma unroll
                for (int r = 0; r < 4; ++r) { v[r][i].x *= g4.x; v[r][i].y *= g4.y; v[r][i].z *= g4.z; v[r][i].w *= g4.w; }
            }
        }
#pragma unroll
        for (int r = 0; r < 4; ++r) {
            float mx = 0.f;
#pragma unroll
            for (int i = 0; i < 4; ++i)
                mx = fmaxf(mx, fmaxf(fmaxf(fabsf(v[r][i].x), fabsf(v[r][i].y)), fmaxf(fabsf(v[r][i].z), fabsf(v[r][i].w))));
            mx = wmaxf(mx);
            const float q = mx > 0.f ? 224.f / mx : 1.f;
            unsigned* dst = (unsigned*)(a.ws + (tb ? O_PVB : O_PU) + (size_t)(e0 + r) * 1024);
#pragma unroll
            for (int i = 0; i < 4; ++i) {
                int w = __builtin_amdgcn_cvt_pk_fp8_f32(v[r][i].x * q, v[r][i].y * q, 0, false);
                w = __builtin_amdgcn_cvt_pk_fp8_f32(v[r][i].z * q, v[r][i].w * q, w, true);
                dst[lane + 64 * i] = (unsigned)w;
            }
            if (lane == 0) WSP(float, O_PSC)[tb * 16384 + e0 + r] = mx > 0.f ? mx * (1.f / 224.f) : 1.f;
        }
    }
}

DEV void ph_mem1(const Args& a) {
    for (int l = 0; l < NL; ++l)
        rmsnorm_rows(a.in[I_MEM], a.in[I_MEMN] + l * 1024, WSP(bf16_t, O_MEMH) + (size_t)l * 512 * 1024, 512);
}
DEV void ph_mem2(const Args& a, unsigned char* smem) {
    for (int it = blockIdx.x; it < 64; it += gridDim.x) {
        const int l = it >> 5, which = (it >> 4) & 1, mt = (it >> 2) & 3, nt = it & 3;
        const bf16_t* A = WSP(bf16_t, O_MEMH) + (size_t)l * 512 * 1024 + (size_t)mt * 128 * 1024;
        const bf16_t* Bt = WSP(bf16_t, which ? O_XWVT : O_XWKT) + (size_t)l * 512 * 1024 + (size_t)nt * 128 * 1024;
        float* o = WSP(float, O_XKVT) + (size_t)(l * 2 + which) * 512 * 512;
        f32x4 acc[4][4];
        acc_zero(acc);
        gemm_kloop<4, 4>(smem, 1024, [&](int r, int k0) { return A + (size_t)r * 1024 + k0; },
                                [&](int n, int k0) { return Bt + (size_t)n * 1024 + k0; }, acc);
        gemm_epi<4, 4>(acc, [&](int row, int col, float v) { o[(size_t)(mt * 128 + row) * 512 + nt * 128 + col] = v; });
    }
}
DEV void ph_mem3(const Args& a) {
    const int wave = threadIdx.x >> 6, lane = threadIdx.x & 63;
    for (int rw = blockIdx.x * 4 + wave; rw < NL * 512; rw += gridDim.x * 4) {
        const int l = rw >> 9, r = rw & 511, b = r >> 8, m = r & 255;
        const float* kr = WSP(float, O_XKVT) + ((size_t)(l * 2 + 0) * 512 + r) * 512 + lane * 8;
        const float* vr = WSP(float, O_XKVT) + ((size_t)(l * 2 + 1) * 512 + r) * 512 + lane * 8;
        const int h = lane >> 4, d0 = (lane & 15) * 8;
        const float* kn = a.in[I_XKN] + l * 128;
        float f[8], ss = 0.f;
#pragma unroll
        for (int i = 0; i < 8; ++i) { f[i] = kr[i]; ss += f[i] * f[i]; }
        ss = sum8(ss); ss += __shfl_xor(ss, 8);
        const float rs = rsqrtf(ss * (1.f / 128.f) + EPS);
        u32x4 o;
        o.x = pk2(f[0] * rs * kn[d0 + 0], f[1] * rs * kn[d0 + 1]);
        o.y = pk2(f[2] * rs * kn[d0 + 2], f[3] * rs * kn[d0 + 3]);
        o.z = pk2(f[4] * rs * kn[d0 + 4], f[5] * rs * kn[d0 + 5]);
        o.w = pk2(f[6] * rs * kn[d0 + 6], f[7] * rs * kn[d0 + 7]);
        *(u32x4*)(WSP(bf16_t, O_XK) + ((size_t)((l * 2 + b) * 4 + h) * 256 + m) * 128 + d0) = o;
        bf16_t* vt = WSP(bf16_t, O_XVT) + ((size_t)((l * 2 + b) * 4 + h) * 128 + d0) * 256 + m;
#pragma unroll
        for (int i = 0; i < 8; ++i) vt[(size_t)i * 256] = (bf16_t)f2bf(vr[i]);
    }
}

DEV void ph_gemm1(const Args& a, int l, unsigned char* smem, bool with_peercvt) {
    const bf16_t* A = WSP(bf16_t, O_XN);
    const bf16_t* Bt = WSP(bf16_t, O_WINT) + (size_t)l * INW * 1024;
    bf16_t* z = WSP(bf16_t, O_ZBUF);
    const float* rsp = WSP(float, O_RSS);
    int kslice = 0;
    for (TileIter ti(256, 8); ti.valid(); ti.next()) {
        const int mt = ti.mt(), nt = ti.nt();
        const int m0 = mt * 128, n0 = nt * 256;
        if (with_peercvt) { ph_peercvt(a, l, kslice, kslice + 1); ++kslice; }
        if (nt < 7) {
            f32x4 acc[4][8];
            acc_zero(acc);
            gemm_kloop32<4, 8>(smem, 1024, [&](int r, int k0) { return A + (size_t)(m0 + r) * 1024 + k0; },
                               [&](int n, int k0) { return Bt + (size_t)(n0 + n) * 1024 + k0; }, acc);
            const int lane = threadIdx.x & 63, wave = threadIdx.x >> 6, wm = wave >> 1, wn = wave & 1, fr = lane & 15, fq = lane >> 4;
#pragma unroll
            for (int m = 0; m < 4; ++m)
#pragma unroll
                for (int j = 0; j < 4; ++j) {
                    const int row = m0 + wm * 64 + m * 16 + fq * 4 + j;
                    const float rs = row_rstd(rsp, row);
#pragma unroll
                    for (int n = 0; n < 8; ++n) z[(size_t)row * NZ + n0 + wn * 128 + n * 16 + fr] = (bf16_t)f2bf(acc[m][n][j] * rs);
                }
        } else {
            f32x4 acc[4][9];
            acc_zero(acc);
            gemm_kloop32<4, 9>(smem, 1024, [&](int r, int k0) { return A + (size_t)(m0 + r) * 1024 + k0; },
                               [&](int n, int k0) { return Bt + (size_t)(n0 + n) * 1024 + k0; }, acc);
            const int lane = threadIdx.x & 63, wave = threadIdx.x >> 6, wm = wave >> 1, wn = wave & 1, fr = lane & 15, fq = lane >> 4;
#pragma unroll
            for (int m = 0; m < 4; ++m)
#pragma unroll
                for (int j = 0; j < 4; ++j) {
                    const int row = m0 + wm * 64 + m * 16 + fq * 4 + j;
                    const float rs = row_rstd(rsp, row);
#pragma unroll
                    for (int n = 0; n < 9; ++n) {
                        const int col = n0 + wn * 144 + n * 16 + fr;
                        if (col < NZ) z[(size_t)row * NZ + col] = (bf16_t)f2bf(acc[m][n][j] * rs);
                    }
                }
        }
    }
    if (with_peercvt) ph_peercvt(a, l, kslice);
}

DEV void ph_post(const Args& a, int l, unsigned char* smem) {
    const bf16_t* zb = WSP(bf16_t, O_ZBUF);
    bf16_t* vt = (bf16_t*)smem;
    const float* qnw = a.in[I_QN] + l * 64;
    const float* knw = a.in[I_KN] + l * 192;
    const float* lng = a.in[I_LNG] + l * 256;
    const float* lnb = a.in[I_LNB] + l * 256;
    const int tid = threadIdx.x, wave = tid >> 6, lane = tid & 63;
    for (int it = blockIdx.x; it < T / 64; it += gridDim.x) {
        const int t0 = it * 64, b = t0 / S, s0 = t0 - b * S;
        __syncthreads();
        float wsum_[8];
#pragma unroll
        for (int e = 0; e < 8; ++e) wsum_[e] = 0.f;
        u32x4 nq, nkv, nsg, npl;
        {
            const bf16_t* row0 = zb + (size_t)(t0 + wave * 16) * NZ;
            nq = *(const u32x4*)(row0 + 8 * lane);
            nkv = *(const u32x4*)(row0 + 768 + 8 * lane);
            nsg = *(const u32x4*)(row0 + ZSGU + 8 * lane);
            npl = *(const u32x4*)(row0 + ZPOOL + 8 * (lane & 31));
        }
        for (int i = 0; i < 16; ++i) {
            const int tl = wave * 16 + i, t = t0 + tl, s = s0 + tl;
            const bf16_t* row = zb + (size_t)t * NZ;
            const u32x4 cq = nq, ckv = nkv, csg = nsg, cpl = npl;
            if (i + 1 < 16) {
                nq = *(const u32x4*)(row + NZ + 8 * lane);
                nkv = *(const u32x4*)(row + NZ + 768 + 8 * lane);
                nsg = *(const u32x4*)(row + NZ + ZSGU + 8 * lane);
                npl = *(const u32x4*)(row + NZ + ZPOOL + 8 * (lane & 31));
            }
            {
                const u32x4 r = cq;
                float f[8]; unpack8(r, f);
                float ss = 0.f;
#pragma unroll
                for (int e = 0; e < 8; ++e) ss += f[e] * f[e];
                ss = sum8(ss);
                const float rs = rsqrtf(ss * (1.f / 64.f) + EPS) * (0.125f * LOG2E);
                const int d0 = (lane & 7) * 8;
                u32x4 o;
                o.x = pk2(f[0] * rs * qnw[d0 + 0], f[1] * rs * qnw[d0 + 1]);
                o.y = pk2(f[2] * rs * qnw[d0 + 2], f[3] * rs * qnw[d0 + 3]);
                o.z = pk2(f[4] * rs * qnw[d0 + 4], f[5] * rs * qnw[d0 + 5]);
                o.w = pk2(f[6] * rs * qnw[d0 + 6], f[7] * rs * qnw[d0 + 7]);
                *(u32x4*)(WSP(bf16_t, O_QN) + (size_t)t * 512 + 8 * lane) = o;
            }
            {
                const u32x4 r = ckv;
                const int c6 = 2 + (lane >> 4), g = (lane >> 3) & 1, d0 = (lane & 7) * 8;
                float f[8]; unpack8(r, f);
                float ss = 0.f;
#pragma unroll
                for (int e = 0; e < 8; ++e) ss += f[e] * f[e];
                ss = sum8(ss);
                if ((c6 & 1) == 0) {
                    const float* kn = knw + (c6 == 2 ? 64 : 128);
                    const float rs = rsqrtf(ss * (1.f / 64.f) + EPS);
                    u32x4 o;
                    o.x = pk2(f[0] * rs * kn[d0 + 0], f[1] * rs * kn[d0 + 1]);
                    o.y = pk2(f[2] * rs * kn[d0 + 2], f[3] * rs * kn[d0 + 3]);
                    o.z = pk2(f[4] * rs * kn[d0 + 4], f[5] * rs * kn[d0 + 5]);
                    o.w = pk2(f[6] * rs * kn[d0 + 6], f[7] * rs * kn[d0 + 7]);
                    bf16_t* dst = WSP(bf16_t, c6 == 2 ? O_KSLC : O_KWIN) + ((size_t)((b * 2 + g) * S + s)) * 64 + d0;
                    *(u32x4*)dst = o;
                } else {
                    const int which = (c6 - 3) >> 1;
                    bf16_t* dst = vt + ((which * 2 + g) * 64 + d0) * 72 + tl;
                    const unsigned w[4] = {r.x, r.y, r.z, r.w};
#pragma unroll
                    for (int e = 0; e < 4; ++e) {
                        dst[(2 * e) * 72] = (bf16_t)(w[e] & 0xffffu);
                        dst[(2 * e + 1) * 72] = (bf16_t)(w[e] >> 16);
                    }
                }
            }
            if (lane < 24) {
                const float z = bflo((unsigned)row[ZG + lane]);
                WSP(float, O_GATE)[(size_t)t * 24 + lane] = sigmoidf_(z);
            }
            {
                const u32x4 r = csg;
                float f[8]; unpack8(r, f);
                float sm = 0.f;
#pragma unroll
                for (int e = 0; e < 8; ++e) { f[e] = gelu_t(f[e]); sm += f[e]; }
                sm = sum16(sm);
                sm += __shfl_xor(sm, 16);
                const float mu = sm * (1.f / 256.f);
                float vr = 0.f;
#pragma unroll
                for (int e = 0; e < 8; ++e) vr += (f[e] - mu) * (f[e] - mu);
                vr = sum16(vr);
                vr += __shfl_xor(vr, 16);
                const float rs = rsqrtf(vr * (1.f / 256.f) + EPS);
                u32x4 o;
                if (lane < 32) {
                    o.x = pk2(f[0], f[1]); o.y = pk2(f[2], f[3]); o.z = pk2(f[4], f[5]); o.w = pk2(f[6], f[7]);
                    *(u32x4*)(WSP(bf16_t, O_UG) + (size_t)t * 256 + 8 * lane) = o;
                } else {
                    const int c0 = 8 * (lane - 32);
                    float y[8];
#pragma unroll
                    for (int e = 0; e < 8; ++e) y[e] = (f[e] - mu) * rs * lng[c0 + e] + lnb[c0 + e];
                    o.x = pk2(y[0], y[1]); o.y = pk2(y[2], y[3]); o.z = pk2(y[4], y[5]); o.w = pk2(y[6], y[7]);
                    *(u32x4*)(WSP(bf16_t, O_VLN) + (size_t)t * 256 + c0) = o;
                }
            }
            if (lane < 32) {
                const int gi = lane >> 3, w = 2 << gi, c0 = 8 * lane;
                float p[8];
                unpack8(cpl, p);
                if (i == 0) {
#pragma unroll
                    for (int e = 0; e < 8; ++e) wsum_[e] = 0.f;
                    for (int k = 1; k < 16; ++k) {
                        if (k < w && s - k >= 0) {
                            const u32x4 r = *(const u32x4*)(row - (size_t)k * NZ + ZPOOL + c0);
                            float f[8]; unpack8(r, f);
#pragma unroll
                            for (int e = 0; e < 8; ++e) wsum_[e] += f[e];
                        }
                    }
                } else if (s - w >= 0) {
                    const u32x4 r = *(const u32x4*)(row - (size_t)w * NZ + ZPOOL + c0);
                    float f[8]; unpack8(r, f);
#pragma unroll
                    for (int e = 0; e < 8; ++e) wsum_[e] -= f[e];
                }
#pragma unroll
                for (int e = 0; e < 8; ++e) wsum_[e] += p[e];
                const float ic = 1.f / (float)min(s + 1, w);
                u32x4 o;
                o.x = pk2(wsum_[0] * ic - p[0], wsum_[1] * ic - p[1]);
                o.y = pk2(wsum_[2] * ic - p[2], wsum_[3] * ic - p[3]);
                o.z = pk2(wsum_[4] * ic - p[4], wsum_[5] * ic - p[5]);
                o.w = pk2(wsum_[6] * ic - p[6], wsum_[7] * ic - p[7]);
                *(u32x4*)(WSP(bf16_t, O_DPOOL) + (size_t)t * 256 + c0) = o;
            }
        }
        __syncthreads();
        {
            const int which = tid >> 7, g = (tid >> 6) & 1, d = tid & 63;
            const bf16_t* src = vt + tid * 72;
            bf16_t* dst = WSP(bf16_t, which ? O_VWINT : O_VSLCT) + ((size_t)((b * 2 + g) * 64 + d)) * S + s0;
#pragma unroll
            for (int j = 0; j < 8; ++j) *(u32x4*)(dst + 8 * j) = *(const u32x4*)(src + 8 * j);
        }
    }
}

DEV void ph_cmp1(const Args& a, int l, unsigned char* smem) {
    const bf16_t* zb = WSP(bf16_t, O_ZBUF);
    const bf16_t* W1T = WSP(bf16_t, O_W1T) + (size_t)(l * 2) * 128 * 2048;
    const float* pw1 = WSP(float, O_PW1) + l * 256;
    bf16_t* hid = WSP(bf16_t, O_HID);
    for (int it = blockIdx.x; it < 256; it += gridDim.x) {
        const int c = it >> 7, mt = (it >> 1) & 63, nt = it & 1, m0 = mt * 64, n0 = nt * 64;
        f32x4 acc[2][2];
        acc_zero(acc);
        gemm_kloop<2, 2>(smem, 2048,
            [&](int r, int k0) {
                const int m = m0 + r, bg = m >> 10, n = min(m & 1023, 1022), b = bg >> 1, g = bg & 1;
                return zb + ((size_t)(b * S + 16 * n + (k0 >> 6))) * NZ + ZKV + c * 128 + g * 64;
            },
            [&](int n, int k0) { return W1T + ((size_t)(c * 128 + n0 + n)) * 2048 + k0; }, acc);
        gemm_epi<2, 2>(acc, [&](int row, int col, float v) {
            hid[((size_t)(c * 4096 + m0 + row)) * 128 + n0 + col] = (bf16_t)f2bf(gelu_t(v + pw1[c * 128 + n0 + col]));
        });
    }
}
DEV void ph_cmp2(const Args& a, int l) {
    const float* w2 = a.in[I_W2] + (size_t)l * 2 * 128 * 64;
    const float* kn0 = a.in[I_KN] + l * 192;
    const bf16_t* hid = WSP(bf16_t, O_HID);
    const int wave = threadIdx.x >> 6, lane = threadIdx.x & 63;
    for (int rw = blockIdx.x * 4 + wave; rw < 8192; rw += gridDim.x * 4) {
        const int c = rw >> 12, m = rw & 4095, bg = m >> 10, n = m & 1023;
        const bf16_t* h = hid + ((size_t)(c * 4096 + m)) * 128;
        float acc = 0.f;
        for (int e = 0; e < 128; ++e) acc += bflo((unsigned)h[e]) * w2[(c * 128 + e) * 64 + lane];
        if (c == 0) {
            const float ss = wsum(acc * acc);
            const float v = acc * rsqrtf(ss * (1.f / 64.f) + EPS) * kn0[lane];
            WSP(bf16_t, O_KC)[((size_t)(bg * 1024 + n)) * 64 + lane] = (n < 1023) ? (bf16_t)f2bf(v) : (bf16_t)0;
        } else {
            WSP(bf16_t, O_VCT)[((size_t)(bg * 64 + lane)) * 1024 + n] = (n < 1023) ? (bf16_t)f2bf(acc) : (bf16_t)0;
        }
    }
}

DEV bf16x8 packp(const float* pa, const float* pb) {
    u32x4 w;
    w.x = pk2(pa[0], pa[1]); w.y = pk2(pa[2], pa[3]); w.z = pk2(pb[0], pb[1]); w.w = pk2(pb[2], pb[3]);
    return __builtin_bit_cast(bf16x8, w);
}
constexpr float NEGBIG = -1.0e30f;
DEV bf16x8 ones_frag() { const short o = (short)0x3F80; return (bf16x8){o, o, o, o, o, o, o, o}; }
struct KFrag { bf16x8 ka[2], kb[2]; };
DEV void k_load(KFrag& f, const bf16_t* __restrict__ kb, int kb0, int q4, int ia) {
#pragma unroll
    for (int ks = 0; ks < 2; ++ks) {
        f.ka[ks] = ld8(kb + (size_t)(kb0 + ia) * 64 + ks * 32 + q4 * 8);
        f.kb[ks] = ld8(kb + (size_t)(kb0 + ia + 4) * 64 + ks * 32 + q4 * 8);
    }
}
template <class MaskF, class FullF>
DEV void attn_group(const KFrag& f, const bf16_t* __restrict__ vt, size_t vstride, int G, const bf16x8 (&qf)[4][2], float M0, MaskF valid, FullF full,
                    f32x4 (&o)[4][4], f32x4 (&lacc)[4], int col, int q4) {
    const bf16x8 ones = ones_frag();
    const int kb0 = 32 * G;
    bf16x8 va[4];
#pragma unroll
    for (int dt = 0; dt < 4; ++dt) va[dt] = ld8(vt + (size_t)(dt * 16 + col) * vstride + kb0 + q4 * 8);
    const bool fullg = full(G);
#pragma unroll
    for (int ct = 0; ct < 4; ++ct) {
        f32x4 sa = {-M0, -M0, -M0, -M0}, sb = {-M0, -M0, -M0, -M0};
        if (!fullg) {
#pragma unroll
            for (int e = 0; e < 4; ++e) {
                const int key = kb0 + 8 * q4 + e;
                sa[e] = valid(ct, key) ? -M0 : NEGBIG;
                sb[e] = valid(ct, key + 4) ? -M0 : NEGBIG;
            }
        }
#pragma unroll
        for (int ks = 0; ks < 2; ++ks) { sa = mfma16(f.ka[ks], qf[ct][ks], sa); sb = mfma16(f.kb[ks], qf[ct][ks], sb); }
        float pa[4], pb[4];
#pragma unroll
        for (int e = 0; e < 4; ++e) { pa[e] = fexp2(sa[e]); pb[e] = fexp2(sb[e]); }
        const bf16x8 pf = packp(pa, pb);
#pragma unroll
        for (int dt = 0; dt < 4; ++dt) o[ct][dt] = mfma16(va[dt], pf, o[ct][dt]);
        lacc[ct] = mfma16(ones, pf, lacc[ct]);
    }
}
template <class MaskF, class FullF>
DEV void attn_shared(const bf16_t* __restrict__ kb, const bf16_t* __restrict__ vt, size_t vstride, int G0, int G1, const bf16x8 (&qf)[4][2],
                     float M0, MaskF valid, FullF full, f32x4 (&o)[4][4], f32x4 (&lacc)[4], int col, int q4, int ia) {
    if (G0 > G1) return;
    KFrag fa, fb;
    k_load(fa, kb, 32 * G0, q4, ia);
    for (int G = G0; G <= G1; G += 2) {
        if (G + 1 <= G1) k_load(fb, kb, 32 * (G + 1), q4, ia);
        attn_group(fa, vt, vstride, G, qf, M0, valid, full, o, lacc, col, q4);
        if (G + 1 <= G1) {
            if (G + 2 <= G1) k_load(fa, kb, 32 * (G + 2), q4, ia);
            attn_group(fb, vt, vstride, G + 1, qf, M0, valid, full, o, lacc, col, q4);
        }
    }
}

template <class MaskF, class FullF>
DEV void attn_ring(unsigned char* smem, int tid_, const bf16_t* __restrict__ ksrc, const bf16_t* __restrict__ vsrc, size_t vstride, int jlo, int jhi,
                   const bf16x8 (&qf)[4][2], float M0, MaskF valid, FullF full, f32x4 (&o)[4][4], f32x4 (&lacc)[4], int col, int q4, int ia) {
    if (jlo <= jhi) {
        const bf16x8 ones = ones_frag();
        int sR[2], sC[2];
#pragma unroll
        for (int i = 0; i < 2; ++i) stage_rc(tid_ * 16 + i * 4096, sR[i], sC[i]);
        auto stage = [&](int j, int buf) {
            unsigned char* Kb = smem + buf * 16384;
#pragma unroll
            for (int i = 0; i < 2; ++i) {
                glds16(ksrc + (size_t)(64 * j + sR[i]) * 64 + sC[i], Kb + tid_ * 16 + i * 4096);
                glds16(vsrc + (size_t)sR[i] * vstride + 64 * j + sC[i], Kb + 8192 + tid_ * 16 + i * 4096);
            }
        };
        const int ka_off = ((ia >> 4) * 2048) + (((ia & 15) * 64 + q4 * 16) ^ ((((ia & 15) >> 3) & 1) << 5));
        const int kb_off = (((ia + 4) >> 4) * 2048) + ((((ia + 4) & 15) * 64 + q4 * 16) ^ (((((ia + 4) & 15) >> 3) & 1) << 5));
        const int v_off = (col * 64 + q4 * 16) ^ (((col >> 3) & 1) << 5);
#pragma unroll
        for (int ct = 0; ct < 4; ++ct)
#pragma unroll
            for (int ks = 0; ks < 2; ++ks) asm volatile("" ::"v"(qf[ct][ks]));
        asm volatile("s_waitcnt vmcnt(0)" ::: "memory");
        stage(jlo, 0);
        if (jlo + 1 <= jhi) stage(jlo + 1, 1);
        int slot = 0;
        for (int j = jlo; j <= jhi; ++j) {
            if (j + 1 <= jhi) asm volatile("s_waitcnt vmcnt(4)" ::: "memory");
            else asm volatile("s_waitcnt vmcnt(0)" ::: "memory");
            __builtin_amdgcn_s_barrier();
            if (j + 2 <= jhi) stage(j + 2, slot >= 1 ? slot - 1 : 2);
            const unsigned char* Kb = smem + slot * 16384;
#pragma unroll
            for (int G2 = 0; G2 < 2; ++G2) {
                bf16x8 ka[2], kbf[2], va[4];
#pragma unroll
                for (int ks = 0; ks < 2; ++ks) {
                    ka[ks] = *(const bf16x8*)(Kb + G2 * 4096 + ks * 1024 + ka_off);
                    kbf[ks] = *(const bf16x8*)(Kb + G2 * 4096 + ks * 1024 + kb_off);
                }
#pragma unroll
                for (int dt = 0; dt < 4; ++dt) va[dt] = *(const bf16x8*)(Kb + 8192 + dt * 2048 + G2 * 1024 + v_off);
                const int kb0 = 64 * j + 32 * G2;
                const bool fullg = full(kb0);
#pragma unroll
                for (int ct = 0; ct < 4; ++ct) {
                    f32x4 sa = {-M0, -M0, -M0, -M0}, sb = {-M0, -M0, -M0, -M0};
                    if (!fullg) {
#pragma unroll
                        for (int e = 0; e < 4; ++e) {
                            const int key = kb0 + 8 * q4 + e;
                            sa[e] = valid(ct, key) ? -M0 : NEGBIG;
                            sb[e] = valid(ct, key + 4) ? -M0 : NEGBIG;
                        }
                    }
#pragma unroll
                    for (int ks = 0; ks < 2; ++ks) { sa = mfma16(ka[ks], qf[ct][ks], sa); sb = mfma16(kbf[ks], qf[ct][ks], sb); }
                    float pa[4], pb[4];
#pragma unroll
                    for (int e = 0; e < 4; ++e) { pa[e] = fexp2(sa[e]); pb[e] = fexp2(sb[e]); }
                    const bf16x8 pf = packp(pa, pb);
#pragma unroll
                    for (int dt = 0; dt < 4; ++dt) o[ct][dt] = mfma16(va[dt], pf, o[ct][dt]);
                    lacc[ct] = mfma16(ones, pf, lacc[ct]);
                }
            }
            slot = (slot == 2) ? 0 : slot + 1;
        }
    }
    __syncthreads();
}

DEV void ph_nsa(const Args& a, int l, unsigned char* smem) {
    const int tid = threadIdx.x, wave = tid >> 6, lane = tid & 63;
#define LANE_VARS int ln_ = lane; asm volatile("" : "+v"(ln_)); const int col = ln_ & 15, q4 = ln_ >> 4, qq = col >> 2, r = col & 3, ia = 8 * (col >> 2) + (col & 3), h = g * 4 + r; (void)ia; (void)h; (void)qq; (void)r; (void)q4;
    const bf16_t* qn = WSP(bf16_t, O_QN);
    const float* gate = WSP(float, O_GATE);
    bf16_t* oa = WSP(bf16_t, O_OA);
    float M0;
    {
        const float* kn = a.in[I_KN] + l * 192;
        const float gq = wmaxf(fabsf(a.in[I_QN][l * 64 + lane]));
        const float gk = wmaxf(fmaxf(fabsf(kn[lane]), fmaxf(fabsf(kn[64 + lane]), fabsf(kn[128 + lane]))));
        M0 = 8.f * gq * gk * LOG2E * 1.01f;
    }
    float* imp = (float*)smem + wave * 2080;
    unsigned* selbits = (unsigned*)(smem + 49152);
    const bool xmap = (gridDim.x % 8) == 0;
    const int it0 = xmap ? ((blockIdx.x & 1) + 2 * (blockIdx.x >> 3)) : blockIdx.x;
    const int itn = xmap ? 256 : 1024;
    const int its = xmap ? (gridDim.x >> 2) : gridDim.x;
    for (int it = it0; it < itn; it += its) {
        const int bg = xmap ? ((blockIdx.x & 7) >> 1) : (it & 3);
        int tt = xmap ? it : (it >> 2);
        tt = (tt < 128) ? tt : (383 - tt);
        const int b = bg >> 1, g = bg & 1, cur = tt;
        const int tw0 = tt * 64 + wave * 16;
#define LOAD_QF(qf) bf16x8 qf[4][2]; _Pragma("unroll") for (int ct = 0; ct < 4; ++ct) _Pragma("unroll") for (int ks = 0; ks < 2; ++ks) \
            qf[ct][ks] = ld8(qn + ((size_t)b * S + tw0 + 4 * ct + qq) * 512 + h * 64 + ks * 32 + q4 * 8);
        const bf16_t* kcb = WSP(bf16_t, O_KC) + (size_t)bg * 1024 * 64;
        const bf16_t* vcb = WSP(bf16_t, O_VCT) + (size_t)bg * 64 * 1024;
        float linv_c[4];
        const int tmax = tw0 + 15;
        const int nvis = tmax >= 31 ? ((tmax - 31) >> 4) + 1 : 0;
        const int ng = (nvis + 31) >> 5;
        for (int rp1 = 0; rp1 < ((REP_ID == 20 && l == 0) ? 2 : 1); ++rp1) {
            LANE_VARS
            LOAD_QF(qf)
            f32x4 o[4][4], lacc[4];
#pragma unroll
            for (int ct = 0; ct < 4; ++ct) {
                lacc[ct] = (f32x4){0.f, 0.f, 0.f, 0.f};
#pragma unroll
                for (int dt = 0; dt < 4; ++dt) o[ct][dt] = (f32x4){0.f, 0.f, 0.f, 0.f};
            }
            {
                const int tmax_tile = tt * 64 + 63;
                const int nvis_tile = tmax_tile >= 31 ? ((tmax_tile - 31) >> 4) + 1 : 0;
                int tid_ = tid;
                asm volatile("" : "+v"(tid_));
                attn_ring(smem, tid_, kcb, vcb, 1024, 0, ((nvis_tile + 63) >> 6) - 1, qf, M0,
                          [&](int ct, int n) { return 16 * n + 31 <= tw0 + 4 * ct + qq; },
                          [&](int n0) { return 16 * n0 + 527 <= tw0; }, o, lacc, col, q4, ia);
            }
#pragma unroll
            for (int ct = 0; ct < 4; ++ct) {
                const float s_ = lacc[ct][0];
                linv_c[ct] = s_ > 0.f ? 1.f / s_ : 0.f;
                const size_t tok = (size_t)b * S + tw0 + 4 * ct + qq;
                const float sc = gate[tok * 24 + h * 3 + 0] * linv_c[ct];
#pragma unroll
                for (int dt = 0; dt < 4; ++dt) {
                    u32x2 w;
                    w.x = pk2(o[ct][dt][0] * sc, o[ct][dt][1] * sc);
                    w.y = pk2(o[ct][dt][2] * sc, o[ct][dt][3] * sc);
                    *(u32x2*)(oa + tok * 1024 + h * 64 + dt * 16 + 4 * q4) = w;
                }
            }
        }
        for (int i = lane; i < 128; i += 64) selbits[wave * 128 + i] = 0u;
        for (int rp2 = 0; rp2 < ((REP_ID == 21 && l == 0) ? 2 : 1); ++rp2)
#pragma unroll 1
        for (int cp = 0; cp < 2; ++cp) {
            LANE_VARS
            const int tq7 = tw0 + 8 * cp + 7;
            const int nv = tq7 >= 31 ? ((tq7 - 31) >> 4) + 1 : 0;
            const int ngc = (nv + 31) >> 5;
            bf16x8 qc[2][2];
#pragma unroll
            for (int c2 = 0; c2 < 2; ++c2)
#pragma unroll
                for (int ks = 0; ks < 2; ++ks) qc[c2][ks] = ld8(qn + ((size_t)b * S + tw0 + 8 * cp + 4 * c2 + qq) * 512 + h * 64 + ks * 32 + q4 * 8);
            for (int i = lane; i < 2080; i += 64) imp[i] = 0.f;
            lds_fence();
            if (cur >= 16) {
                for (int G = 0; G < ngc; ++G) {
                    const int kb0 = 32 * G;
                    bf16x8 ka[2], kb[2];
#pragma unroll
                    for (int ks = 0; ks < 2; ++ks) {
                        ka[ks] = ld8(kcb + (size_t)(kb0 + ia) * 64 + ks * 32 + q4 * 8);
                        kb[ks] = ld8(kcb + (size_t)(kb0 + ia + 4) * 64 + ks * 32 + q4 * 8);
                    }
#pragma unroll
                    for (int c2 = 0; c2 < 2; ++c2) {
                        const int t = tw0 + 8 * cp + 4 * c2 + qq;
                        const float li = (cp == 0) ? (c2 == 0 ? linv_c[0] : linv_c[1]) : (c2 == 0 ? linv_c[2] : linv_c[3]);
                        f32x4 sa, sb;
#pragma unroll
                        for (int e = 0; e < 4; ++e) {
                            const int n = kb0 + 8 * q4 + e;
                            sa[e] = (16 * n + 31 <= t) ? -M0 : NEGBIG;
                            sb[e] = (16 * (n + 4) + 31 <= t) ? -M0 : NEGBIG;
                        }
#pragma unroll
                        for (int ks = 0; ks < 2; ++ks) { sa = mfma16(ka[ks], qc[c2][ks], sa); sb = mfma16(kb[ks], qc[c2][ks], sb); }
                        float p[8];
#pragma unroll
                        for (int e = 0; e < 4; ++e) { p[e] = fexp2(sa[e]) * li; p[e + 4] = fexp2(sb[e]) * li; }
                        const float a0 = sum4(2.f * (p[0] + p[1] + p[2]) + p[3]);
                        const float a1 = sum4(p[3] + 2.f * (p[4] + p[5] + p[6]) + p[7]);
                        const float a2 = sum4(p[7]);
                        if (r == 0) {
                            const int j0 = 8 * G + 2 * q4;
                            float* ip = imp + (4 * c2 + qq) * 260 + j0;
                            atomicAdd(ip, a0);
                            atomicAdd(ip + 1, a1);
                            if (j0 + 2 < 256) atomicAdd(ip + 2, a2);
                        }
                    }
                }
            }
            lds_fence();
#pragma unroll 1
            for (int sub = 0; sub < 2; ++sub) {
                int ln2 = ln_;
                asm volatile("" : "+v"(ln2));
                const int qs = (ln2 >> 4) + 4 * sub, s16 = ln2 & 15;
                int mysel;
                if (cur < 16) {
                    mysel = (s16 <= cur) ? s16 : 0;
                } else {
                    unsigned e[16];
#pragma unroll
                    for (int i = 0; i < 16; ++i) {
                        const int j = s16 + 16 * i;
                        const bool valid = (j >= 1) && (j <= cur - 2);
                        e[i] = valid ? ((__float_as_uint(imp[qs * 260 + j]) & ~255u) | (unsigned)(255 - j)) : 0u;
                    }
                    mysel = (s16 == 0) ? 0 : ((s16 == 1) ? cur : cur - 1);
                    for (int itk = 0; itk < 13; ++itk) {
                        unsigned m = e[0];
#pragma unroll
                        for (int i = 1; i < 16; ++i) m = max(m, e[i]);
                        m = max16u(m);
#pragma unroll
                        for (int i = 0; i < 16; ++i) e[i] = (e[i] == m) ? 0u : e[i];
                        if (s16 == 3 + itk) mysel = 255 - (int)(m & 255u);
                    }
                }
                atomicOr(&selbits[(wave * 16 + 8 * cp + qs) * 8 + (mysel >> 5)], 1u << (mysel & 31));
            }
            lds_fence();
        }
        __syncthreads();
        for (int rp3 = 0; rp3 < ((REP_ID == 22 && l == 0) ? 2 : 1); ++rp3) {
            const bool last3 = (rp3 == ((REP_ID == 22 && l == 0) ? 1 : 0));
            const bf16_t* ksb = WSP(bf16_t, O_KSLC) + (size_t)bg * S * 64;
            const bf16_t* vsb = WSP(bf16_t, O_VSLCT) + (size_t)bg * 64 * S;
            LANE_VARS
            LOAD_QF(qf)
            f32x4 o[4][4], lacc[4];
#pragma unroll
            for (int ct = 0; ct < 4; ++ct) {
                lacc[ct] = (f32x4){0.f, 0.f, 0.f, 0.f};
#pragma unroll
                for (int dt = 0; dt < 4; ++dt) o[ct][dt] = (f32x4){0.f, 0.f, 0.f, 0.f};
            }
            const bf16x8 ones = ones_frag();
            int tid_ = tid;
            asm volatile("" : "+v"(tid_));
            int sR[2], sC[2];
#pragma unroll
            for (int i = 0; i < 2; ++i) stage_rc(tid_ * 16 + i * 4096, sR[i], sC[i]);
            auto stage = [&](int j, int buf) {
                unsigned char* Kb = smem + buf * 16384;
#pragma unroll
                for (int i = 0; i < 2; ++i) {
                    glds16(ksb + (size_t)(64 * j + sR[i]) * 64 + sC[i], Kb + tid_ * 16 + i * 4096);
                    glds16(vsb + (size_t)sR[i] * S + 64 * j + sC[i], Kb + 8192 + tid_ * 16 + i * 4096);
                }
            };
            const int ka_off = ((ia >> 4) * 2048) + (((ia & 15) * 64 + q4 * 16) ^ ((((ia & 15) >> 3) & 1) << 5));
            const int kb_off = (((ia + 4) >> 4) * 2048) + ((((ia + 4) & 15) * 64 + q4 * 16) ^ (((((ia + 4) & 15) >> 3) & 1) << 5));
            const int v_off = (col * 64 + q4 * 16) ^ (((col >> 3) & 1) << 5);
#pragma unroll
            for (int ct = 0; ct < 4; ++ct)
#pragma unroll
                for (int ks = 0; ks < 2; ++ks) asm volatile("" ::"v"(qf[ct][ks]));
            asm volatile("s_waitcnt vmcnt(0)" ::: "memory");
            stage(0, 0);
            if (cur >= 1) stage(1, 1);
            for (int j = 0; j <= cur; ++j) {
                if (j + 1 <= cur) asm volatile("s_waitcnt vmcnt(4)" ::: "memory");
                else asm volatile("s_waitcnt vmcnt(0)" ::: "memory");
                __builtin_amdgcn_s_barrier();
                if (j + 2 <= cur) stage(j + 2, (j + 2) % 3);
                const unsigned char* Kb = smem + (j % 3) * 16384;
                bool sbit[4];
                bool anyw = false;
#pragma unroll
                for (int ct = 0; ct < 4; ++ct) {
                    sbit[ct] = (selbits[(wave * 16 + 4 * ct + qq) * 8 + (j >> 5)] >> (j & 31)) & 1u;
                    anyw = anyw || sbit[ct];
                }
                if (__ballot(anyw) != 0ull) {
#pragma unroll
                    for (int G2 = 0; G2 < 2; ++G2) {
                        bf16x8 ka[2], kbf[2], va[4];
#pragma unroll
                        for (int ks = 0; ks < 2; ++ks) {
                            ka[ks] = *(const bf16x8*)(Kb + G2 * 4096 + ks * 1024 + ka_off);
                            kbf[ks] = *(const bf16x8*)(Kb + G2 * 4096 + ks * 1024 + kb_off);
                        }
#pragma unroll
                        for (int dt = 0; dt < 4; ++dt) va[dt] = *(const bf16x8*)(Kb + 8192 + dt * 2048 + G2 * 1024 + v_off);
#pragma unroll
                        for (int ct = 0; ct < 4; ++ct) {
                            if (__ballot(sbit[ct]) != 0ull) {
                                const float bias = sbit[ct] ? -M0 : NEGBIG;
                                f32x4 sa = {bias, bias, bias, bias}, sb = {bias, bias, bias, bias};
                                if (j == cur) {
                                    const int t = tw0 + 4 * ct + qq;
#pragma unroll
                                    for (int e = 0; e < 4; ++e) {
                                        const int key = 64 * j + 32 * G2 + 8 * q4 + e;
                                        sa[e] = (key <= t) ? bias : NEGBIG;
                                        sb[e] = (key + 4 <= t) ? bias : NEGBIG;
                                    }
                                }
#pragma unroll
                                for (int ks = 0; ks < 2; ++ks) { sa = mfma16(ka[ks], qf[ct][ks], sa); sb = mfma16(kbf[ks], qf[ct][ks], sb); }
                                float pa[4], pb[4];
#pragma unroll
                                for (int e = 0; e < 4; ++e) { pa[e] = fexp2(sa[e]); pb[e] = fexp2(sb[e]); }
                                const bf16x8 pf = packp(pa, pb);
#pragma unroll
                                for (int dt = 0; dt < 4; ++dt) o[ct][dt] = mfma16(va[dt], pf, o[ct][dt]);
                                lacc[ct] = mfma16(ones, pf, lacc[ct]);
                            }
                        }
                    }
                }
            }
#pragma unroll
            for (int ct = 0; ct < 4; ++ct) {
                const float s_ = lacc[ct][0];
                const size_t tok = (size_t)b * S + tw0 + 4 * ct + qq;
                const float sc = last3 ? gate[tok * 24 + h * 3 + 1] / s_ : 0.f;
#pragma unroll
                for (int dt = 0; dt < 4; ++dt) {
                    bf16_t* op = oa + tok * 1024 + h * 64 + dt * 16 + 4 * q4;
                    const u32x2 old = *(const u32x2*)op;
                    u32x2 w;
                    w.x = pk2(bflo(old.x) + o[ct][dt][0] * sc, bfhi(old.x) + o[ct][dt][1] * sc);
                    w.y = pk2(bflo(old.y) + o[ct][dt][2] * sc, bfhi(old.y) + o[ct][dt][3] * sc);
                    *(u32x2*)op = w;
                }
            }
            __syncthreads();
        }
        for (int rp4 = 0; rp4 < ((REP_ID == 23 && l == 0) ? 2 : 1); ++rp4) {
            const bool last4 = (rp4 == ((REP_ID == 23 && l == 0) ? 1 : 0));
            const bf16_t* kwb = WSP(bf16_t, O_KWIN) + (size_t)bg * S * 64;
            const bf16_t* vwb = WSP(bf16_t, O_VWINT) + (size_t)bg * 64 * S;
            LANE_VARS
            LOAD_QF(qf)
            f32x4 o[4][4], lacc[4];
#pragma unroll
            for (int ct = 0; ct < 4; ++ct) {
                lacc[ct] = (f32x4){0.f, 0.f, 0.f, 0.f};
#pragma unroll
                for (int dt = 0; dt < 4; ++dt) o[ct][dt] = (f32x4){0.f, 0.f, 0.f, 0.f};
            }
            {
                int tid_ = tid;
                asm volatile("" : "+v"(tid_));
                attn_ring(smem, tid_, kwb, vwb, (size_t)S, max(0, tt * 64 - 511) >> 6, tt, qf, M0,
                          [&](int ct, int key) { const int t = tw0 + 4 * ct + qq; return key <= t && t - key < 512; },
                          [&](int k0) { return k0 + 31 <= tw0 && tw0 + 15 - k0 < 512; }, o, lacc, col, q4, ia);
            }
#pragma unroll
            for (int ct = 0; ct < 4; ++ct) {
                const float s_ = lacc[ct][0];
                const size_t tok = (size_t)b * S + tw0 + 4 * ct + qq;
                const float sc = last4 ? gate[tok * 24 + h * 3 + 2] / s_ : 0.f;
#pragma unroll
                for (int dt = 0; dt < 4; ++dt) {
                    bf16_t* op = oa + tok * 1024 + h * 64 + dt * 16 + 4 * q4;
                    const u32x2 old = *(const u32x2*)op;
                    u32x2 w;
                    w.x = pk2(bflo(old.x) + o[ct][dt][0] * sc, bfhi(old.x) + o[ct][dt][1] * sc);
                    w.y = pk2(bflo(old.y) + o[ct][dt][2] * sc, bfhi(old.y) + o[ct][dt][3] * sc);
                    *(u32x2*)op = w;
                }
            }
        }
        __syncthreads();
    }
}

DEV void ph_sgu(const Args& a, int l, unsigned char* smem) {
    const bf16_t* W = WSP(bf16_t, O_SGUW) + (size_t)l * 4 * 128 * 128;
    const bf16_t* vln = WSP(bf16_t, O_VLN);
    const bf16_t* ug = WSP(bf16_t, O_UG);
    const float* sb = a.in[I_SGUB] + l * 512;
    bf16_t* ob = WSP(bf16_t, O_OA);
    for (int it = blockIdx.x; it < 1024; it += gridDim.x) {
        const int ch = it >> 2, g = it & 3, tc0 = ch * 128;
        f32x16 acc[2][1];
        acc_zero_rs(acc);
        gemm_kloop_rs<2, 1, true>(smem, 128, [&](int r, int k0) { return W + (size_t)(g * 128 + r) * 128 + k0; },
                               [&](int kl, int k0) { return vln + (size_t)(tc0 + k0 + kl) * 256 + g * 64; }, acc);
        gemm_epi_rs<2, 1>(acc, [&](int row, int col, float v) {
            const size_t idx = (size_t)(tc0 + row) * 256 + g * 64 + col;
            ob[(size_t)(tc0 + row) * 1024 + 512 + g * 64 + col] = (bf16_t)f2bf(bflo((unsigned)ug[idx]) * (v + sb[g * 128 + row]));
        });
    }
}
DEV void ph_pool(const Args& a, int l, unsigned char* smem) {
    const bf16_t* dp = WSP(bf16_t, O_DPOOL);
    const bf16_t* PT = WSP(bf16_t, O_POOLT) + (size_t)l * 4 * 4096;
    const float* sc = a.in[I_POOLS] + l * 256;
    bf16_t* oc = WSP(bf16_t, O_OA);
    for (int it = blockIdx.x; it < 1024; it += gridDim.x) {
        const int mt = it >> 2, g = it & 3, m0 = mt * 128;
        f32x4 acc[4][2];
        acc_zero(acc);
        gemm_kloop<4, 2>(smem, 64, [&](int r, int k0) { return dp + (size_t)(m0 + r) * 256 + g * 64 + k0; },
                                [&](int n, int k0) { return PT + (size_t)(g * 64 + n) * 64 + k0; }, acc);
        gemm_epi<4, 2>(acc, [&](int row, int col, float v) {
            oc[(size_t)(m0 + row) * 1024 + 768 + g * 64 + col] = (bf16_t)f2bf(v * sc[g * 64 + col]);
        });
    }
}
DEV void ph_merge(const Args& a, int l, unsigned char* smem) {
    const bf16_t* xn = WSP(bf16_t, O_XN);
    const bf16_t* WgT = WSP(bf16_t, O_WINT) + (size_t)l * INW * 1024 + (size_t)NZ * 1024;
    bf16_t* mg = WSP(bf16_t, O_MERGED);
    for (TileIter ti(256, 16); ti.valid(); ti.next()) {
        const int mt = ti.mt(), nt = ti.nt(), m0 = mt * 128, n0 = nt * 64;
        f32x4 accg[4][6];
        acc_zero(accg);
        gemm_kloop32<4, 6>(smem, 1024, [&](int r, int k0) { return xn + (size_t)(m0 + r) * 1024 + k0; },
                           [&](int R, int k0) {
                               const int wnr = R / 96, rem = R - wnr * 96, n = rem >> 4, fr_ = rem & 15;
                               return WgT + (size_t)((n >> 1) * 1024 + n0 + wnr * 32 + (n & 1) * 16 + fr_) * 1024 + k0;
                           }, accg);
        unsigned gpk[4][6][2];
        {
            const float* rsp = WSP(float, O_RSS);
            const int lane_ = threadIdx.x & 63, wm_ = (threadIdx.x >> 6) >> 1, fq_ = lane_ >> 4;
#pragma unroll
            for (int mi = 0; mi < 4; ++mi) {
                float rs4[4];
#pragma unroll
                for (int j = 0; j < 4; ++j) rs4[j] = row_rstd(rsp, m0 + wm_ * 64 + mi * 16 + fq_ * 4 + j);
#pragma unroll
                for (int ni = 0; ni < 6; ++ni) {
                    gpk[mi][ni][0] = pk2(sigmoidf_(accg[mi][ni][0] * rs4[0]), sigmoidf_(accg[mi][ni][1] * rs4[1]));
                    gpk[mi][ni][1] = pk2(sigmoidf_(accg[mi][ni][2] * rs4[2]), sigmoidf_(accg[mi][ni][3] * rs4[3]));
                }
            }
        }
        f32x4 accl0[4][2], accl1[4][2], accl2[4][2];
        acc_zero(accl0); acc_zero(accl1); acc_zero(accl2);
        {
            const bf16_t* ocat = WSP(bf16_t, O_OA);
            const bf16_t* lcat = WSP(bf16_t, O_LAT) + (size_t)l * 1024 * 1024;
            gemm_kloop_seg3<4, 2, 8, 4, 4>(smem, [&](int r, int g) { return ocat + (size_t)(m0 + r) * 1024 + g * 64; },
                                           [&](int n, int g) { return lcat + (size_t)(n0 + n) * 1024 + g * 64; }, accl0, accl1, accl2);
        }
        f32x4 accm[4][2];
#pragma unroll
        for (int mi = 0; mi < 4; ++mi)
#pragma unroll
            for (int ni = 0; ni < 2; ++ni) {
                const unsigned a0 = gpk[mi][ni][0], a1 = gpk[mi][ni][1], b0_ = gpk[mi][2 + ni][0], b1_ = gpk[mi][2 + ni][1],
                               c0_ = gpk[mi][4 + ni][0], c1_ = gpk[mi][4 + ni][1];
                accm[mi][ni][0] = bflo(a0) * accl0[mi][ni][0] + bflo(b0_) * accl1[mi][ni][0] + bflo(c0_) * accl2[mi][ni][0];
                accm[mi][ni][1] = bfhi(a0) * accl0[mi][ni][1] + bfhi(b0_) * accl1[mi][ni][1] + bfhi(c0_) * accl2[mi][ni][1];
                accm[mi][ni][2] = bflo(a1) * accl0[mi][ni][2] + bflo(b1_) * accl1[mi][ni][2] + bflo(c1_) * accl2[mi][ni][2];
                accm[mi][ni][3] = bfhi(a1) * accl0[mi][ni][3] + bfhi(b1_) * accl1[mi][ni][3] + bfhi(c1_) * accl2[mi][ni][3];
            }
        gemm_epi<4, 2>(accm, [&](int row, int col, float v) { mg[(size_t)(m0 + row) * 1024 + n0 + col] = (bf16_t)f2bf(v); });
    }
}
DEV void ph_gemm_resid(const Args& a, const bf16_t* A, int K, const bf16_t* Wt, const float* resid_f32, unsigned char* smem) {
    bf16_t* xb = WSP(bf16_t, O_XN);
    float* rsp = WSP(float, O_RSS);
    for (TileIter ti(256, 4); ti.valid(); ti.next()) {
        const int mt = ti.mt(), nt = ti.nt(), m0 = mt * 128, n0 = nt * 256;
        f32x4 acc[4][8];
        acc_zero(acc);
        gemm_kloop32<4, 8>(smem, K, [&](int r, int k0) { return A + (size_t)(m0 + r) * K + k0; },
                           [&](int n, int k0) { return Wt + (size_t)(n0 + n) * K + k0; }, acc);
        const int lane = threadIdx.x & 63, wave = threadIdx.x >> 6, wm = wave >> 1, wn = wave & 1, fr = lane & 15, fq = lane >> 4;
#pragma unroll
        for (int m = 0; m < 4; ++m)
#pragma unroll
            for (int j = 0; j < 4; ++j) {
                const int row = m0 + wm * 64 + m * 16 + fq * 4 + j;
                float ss = 0.f;
#pragma unroll
                for (int n = 0; n < 8; ++n) {
                    const int col = n0 + wn * 128 + n * 16 + fr;
                    const size_t idx = (size_t)row * 1024 + col;
                    const float xo = resid_f32 ? resid_f32[idx] : bflo((unsigned)xb[idx]);
                    const float v = xo + acc[m][n][j];
                    xb[idx] = (bf16_t)f2bf(v);
                    ss += v * v;
                }
                ss = sum16(ss);
                if (fr == 0) rsp[(size_t)(nt * 2 + wn) * T + row] = ss;
            }
    }
}
DEV void ph_gemm_bf16(const Args& a, const bf16_t* A, const bf16_t* Wt, bf16_t* C, int N, unsigned char* smem) {
    const float* rsp = WSP(float, O_RSS);
    const int ntn = N / 256;
    for (TileIter ti(256, ntn); ti.valid(); ti.next()) {
        const int mt = ti.mt(), nt = ti.nt(), m0 = mt * 128, n0 = nt * 256;
        f32x4 acc[4][8];
        acc_zero(acc);
        gemm_kloop32<4, 8>(smem, 1024, [&](int r, int k0) { return A + (size_t)(m0 + r) * 1024 + k0; },
                           [&](int n, int k0) { return Wt + (size_t)(n0 + n) * 1024 + k0; }, acc);
        const int lane = threadIdx.x & 63, wave = threadIdx.x >> 6, wm = wave >> 1, wn = wave & 1, fr = lane & 15, fq = lane >> 4;
#pragma unroll
        for (int m = 0; m < 4; ++m)
#pragma unroll
            for (int j = 0; j < 4; ++j) {
                const int row = m0 + wm * 64 + m * 16 + fq * 4 + j;
                const float rs = row_rstd(rsp, row);
#pragma unroll
                for (int n = 0; n < 8; ++n) C[(size_t)row * N + n0 + wn * 128 + n * 16 + fr] = (bf16_t)f2bf(acc[m][n][j] * rs);
            }
    }
}

DEV void ph_xatt(const Args& a, int l) {
    const int tid = threadIdx.x, wave = tid >> 6, lane = tid & 63, col = lane & 15, q4 = lane >> 4;
    const bf16_t* xaq = WSP(bf16_t, O_XAQ);
    bf16_t* xao = WSP(bf16_t, O_XAO);
    const float* qnw = a.in[I_XQN] + l * 128;
    float M0;
    {
        const float gq = wmaxf(fmaxf(fabsf(qnw[lane]), fabsf(qnw[64 + lane])));
        const float* kn = a.in[I_XKN] + l * 128;
        const float gk = wmaxf(fmaxf(fabsf(kn[lane]), fabsf(kn[64 + lane])));
        M0 = 11.313708499f * gq * gk * LOG2E * 1.01f;
    }
    const int ia = 8 * (col >> 2) + (col & 3);
    const bf16x8 ones = ones_frag();
    for (int it = blockIdx.x; it < 1024; it += gridDim.x) {
        const int bh = it & 7, tt = it >> 3, b = bh >> 2, hd = bh & 3;
        const int t0 = tt * 128 + wave * 32;
        bf16x8 qf[2][4];
#pragma unroll
        for (int ct = 0; ct < 2; ++ct) {
            const size_t tok = (size_t)b * S + t0 + 16 * ct + col;
            float f[4][8];
            float ss = 0.f;
#pragma unroll
            for (int ks = 0; ks < 4; ++ks) {
                const u32x4 rr = *(const u32x4*)(xaq + tok * 512 + hd * 128 + ks * 32 + q4 * 8);
                unpack8(rr, f[ks]);
#pragma unroll
                for (int e = 0; e < 8; ++e) ss += f[ks][e] * f[ks][e];
            }
            ss += __shfl_xor(ss, 16);
            ss += __shfl_xor(ss, 32);
            const float rs = rsqrtf(ss * (1.f / 128.f) + EPS) * (0.08838834764831845f * LOG2E);
#pragma unroll
            for (int ks = 0; ks < 4; ++ks) {
                const float* gw = qnw + ks * 32 + q4 * 8;
                u32x4 w;
                w.x = pk2(f[ks][0] * rs * gw[0], f[ks][1] * rs * gw[1]);
                w.y = pk2(f[ks][2] * rs * gw[2], f[ks][3] * rs * gw[3]);
                w.z = pk2(f[ks][4] * rs * gw[4], f[ks][5] * rs * gw[5]);
                w.w = pk2(f[ks][6] * rs * gw[6], f[ks][7] * rs * gw[7]);
                qf[ct][ks] = __builtin_bit_cast(bf16x8, w);
            }
        }
        const bf16_t* kb_ = WSP(bf16_t, O_XK) + (size_t)((l * 2 + b) * 4 + hd) * 256 * 128;
        const bf16_t* vb_ = WSP(bf16_t, O_XVT) + (size_t)((l * 2 + b) * 4 + hd) * 128 * 256;
        f32x4 o[2][8], lacc[2];
#pragma unroll
        for (int ct = 0; ct < 2; ++ct) {
            lacc[ct] = (f32x4){0.f, 0.f, 0.f, 0.f};
#pragma unroll
            for (int dt = 0; dt < 8; ++dt) o[ct][dt] = (f32x4){0.f, 0.f, 0.f, 0.f};
        }
        for (int G = 0; G < 8; ++G) {
            const int kb0 = 32 * G;
            bf16x8 pf[2];
            {
                bf16x8 ka[4], kb[4];
#pragma unroll
                for (int ks = 0; ks < 4; ++ks) {
                    ka[ks] = ld8(kb_ + (size_t)(kb0 + ia) * 128 + ks * 32 + q4 * 8);
                    kb[ks] = ld8(kb_ + (size_t)(kb0 + ia + 4) * 128 + ks * 32 + q4 * 8);
                }
#pragma unroll
                for (int ct = 0; ct < 2; ++ct) {
                    f32x4 sa = {-M0, -M0, -M0, -M0}, sb = {-M0, -M0, -M0, -M0};
#pragma unroll
                    for (int ks = 0; ks < 4; ++ks) { sa = mfma16(ka[ks], qf[ct][ks], sa); sb = mfma16(kb[ks], qf[ct][ks], sb); }
                    float pa[4], pb[4];
#pragma unroll
                    for (int e = 0; e < 4; ++e) { pa[e] = fexp2(sa[e]); pb[e] = fexp2(sb[e]); }
                    pf[ct] = packp(pa, pb);
                    lacc[ct] = mfma16(ones, pf[ct], lacc[ct]);
                }
            }
#pragma unroll
            for (int dh = 0; dh < 2; ++dh) {
                bf16x8 va[4];
#pragma unroll
                for (int dt = 0; dt < 4; ++dt) va[dt] = ld8(vb_ + (size_t)((dh * 4 + dt) * 16 + col) * 256 + kb0 + q4 * 8);
#pragma unroll
                for (int ct = 0; ct < 2; ++ct)
#pragma unroll
                    for (int dt = 0; dt < 4; ++dt) o[ct][dh * 4 + dt] = mfma16(va[dt], pf[ct], o[ct][dh * 4 + dt]);
            }
        }
#pragma unroll
        for (int ct = 0; ct < 2; ++ct) {
            const size_t tok = (size_t)b * S + t0 + 16 * ct + col;
            const float inv = 1.f / lacc[ct][0];
#pragma unroll
            for (int dt = 0; dt < 8; ++dt) {
                u32x2 w;
                w.x = pk2(o[ct][dt][0] * inv, o[ct][dt][1] * inv);
                w.y = pk2(o[ct][dt][2] * inv, o[ct][dt][3] * inv);
                *(u32x2*)(xao + tok * 512 + hd * 128 + dt * 16 + 4 * q4) = w;
            }
        }
    }
}

DEV void ph_ptop(const Args& a, int l, unsigned char* smem) {
    const bf16_t* pq = WSP(bf16_t, O_PQ);
    const bf16_t* keys = WSP(bf16_t, O_KEYS) + (size_t)l * 2 * 8192;
    unsigned* ptop = WSP(unsigned, O_PTOP);
    float* sc = (float*)smem;
    const int tid = threadIdx.x;
    for (int it = blockIdx.x; it < 512 * 16; it += gridDim.x) {
        const int tt = it >> 4, hh = it & 15, half = hh & 1, t0 = tt * 64;
        f32x4 acc[2][4];
        acc_zero(acc);
        gemm_kloop<2, 4>(smem, 64, [&](int r, int k0) { return pq + (size_t)(t0 + r) * 1024 + hh * 64 + k0; },
                                [&](int n, int k0) { return keys + (size_t)(half * 128 + n) * 64 + k0; }, acc);
        __syncthreads();
        gemm_epi<2, 4>(acc, [&](int row, int col, float v) { sc[row * 132 + col] = v; });
        __syncthreads();
        {
            const int row = tid >> 2, sub = tid & 3;
            unsigned e[32];
#pragma unroll
            for (int i = 0; i < 32; ++i) {
                const int k = 4 * i + sub;
                e[i] = (f2sort(sc[row * 132 + k]) & ~127u) | (unsigned)(127 - k);
            }
            u32x4 mine = {0u, 0u, 0u, 0u};
#pragma unroll
            for (int itk = 0; itk < 16; ++itk) {
                unsigned m = e[0];
#pragma unroll
                for (int i = 1; i < 32; ++i) m = max(m, e[i]);
                m = max4u(m);
#pragma unroll
                for (int i = 0; i < 32; ++i) e[i] = (e[i] == m) ? 0u : e[i];
                if ((itk >> 2) == sub) mine[itk & 3] = m;
            }
            *(u32x4*)(ptop + ((size_t)(t0 + row) * 16 + hh) * 16 + 4 * sub) = mine;
        }
    }
}

DEV void unpack16_fp8(u32x4 r, float* f) {
    const unsigned w[4] = {r.x, r.y, r.z, r.w};
#pragma unroll
    for (int i = 0; i < 4; ++i) {
        const f32x2 lo = __builtin_amdgcn_cvt_pk_f32_fp8((int)w[i], false);
        const f32x2 hi = __builtin_amdgcn_cvt_pk_f32_fp8((int)w[i], true);
        f[4 * i] = lo.x; f[4 * i + 1] = lo.y; f[4 * i + 2] = hi.x; f[4 * i + 3] = hi.y;
    }
}
DEV void ph_pexp(const Args& a, int l, bool dry, unsigned char* smem) {
    const int wave = threadIdx.x >> 6, lane = threadIdx.x & 63;
    const bf16_t* hf = WSP(bf16_t, O_XN);
    const unsigned* ptop = WSP(unsigned, O_PTOP);
    const unsigned char* U = a.ws + O_PU;
    const unsigned char* V = a.ws + O_PVB;
    const float* psc = WSP(float, O_PSC);
    int ci, cj;
    {
        const int L = lane;
        const int i = (L >= 16) + (L >= 24) + (L >= 29) + (L >= 33) + (L >= 36) + (L >= 38) + (L >= 40) + (L >= 42) + (L >= 43) + (L >= 44) +
                      (L >= 45) + (L >= 46) + (L >= 47) + (L >= 48) + (L >= 49);
        const int pre = (i == 0) ? 0 : (i == 1) ? 16 : (i == 2) ? 24 : (i == 3) ? 29 : (i == 4) ? 33 : (i == 5) ? 36 : (i == 6) ? 38 : (i == 7) ? 40 : (34 + i);
        ci = i; cj = L - pre;
    }
    for (int t = blockIdx.x * 4 + wave; t < T; t += gridDim.x * 4) {
        float hv[16];
        {
            const u32x4 r0 = *(const u32x4*)(hf + (size_t)t * 1024 + 16 * lane);
            const u32x4 r1 = *(const u32x4*)(hf + (size_t)t * 1024 + 16 * lane + 8);
            unpack8(r0, hv); unpack8(r1, hv + 8);
            const float rs = row_rstd(WSP(float, O_RSS), t);
#pragma unroll
            for (int i = 0; i < 16; ++i) hv[i] *= rs;
        }
        int* lds_e = (int*)smem + (threadIdx.x >> 6) * 1024;
        float* lds_c = (float*)(lds_e + 512);
#pragma unroll 1
        for (int h = 0; h < 8; ++h) {
            unsigned key = 0u;
            if (lane < 32) key = ptop[((size_t)t * 16 + 2 * h) * 16 + lane];
            const float val = sort2f(key & ~127u);
            const int idx = 127 - (int)(key & 127u);
            const float v1 = __shfl(val, ci), v2 = __shfl(val, 16 + cj);
            unsigned ck = (lane < 50) ? ((f2sort(v1 + v2) & ~255u) | (unsigned)(255 - (ci * 16 + cj))) : 0u;
            int rank = 0;
#pragma unroll
            for (int j = 0; j < 50; ++j) {
                const unsigned cjv = (unsigned)__builtin_amdgcn_readlane((int)ck, j);
                rank += (cjv > ck) ? 1 : 0;
            }
            const int tgt = (lane < 50) ? rank : lane;
            const unsigned mykey = (unsigned)__builtin_amdgcn_ds_permute(tgt * 4, (int)ck);
            const float cv = sort2f(mykey & ~255u);
            const int p = 255 - (int)(mykey & 255u);
            const int ea = __shfl(idx, (p >> 4) & 15), eb = __shfl(idx, 16 + (p & 15));
            const int eid = (ea * 128 + eb) & 16383;
            const float su = psc[eid], sv = psc[16384 + eid];
            const float mx = __shfl(cv, 0);
            float ex = (lane < 16) ? __expf(cv - mx) : 0.f;
            float sm = ex;
            sm = sum16(sm);
            const float gk = ex / sm;
            float d[16];
            {
                u32x4 rr[16];
#pragma unroll
                for (int k = 0; k < 16; ++k) {
                    const int ek = __builtin_amdgcn_readlane(eid, k);
                    rr[k] = *(const u32x4*)(U + (size_t)ek * 1024 + 16 * lane);
                }
#pragma unroll
                for (int k = 0; k < 16; ++k) {
                    float f[16];
                    unpack16_fp8(rr[k], f);
                    float s_ = 0.f;
#pragma unroll
                    for (int i = 0; i < 16; ++i) s_ += f[i] * hv[i];
                    d[k] = s_;
                }
            }
            float d8[8], d4[4], d2[2], d1;
            {
                const bool b5 = (lane & 32) != 0;
#pragma unroll
                for (int i = 0; i < 8; ++i) { const float keep = b5 ? d[i + 8] : d[i], send = b5 ? d[i] : d[i + 8]; d8[i] = keep + __shfl_xor(send, 32); }
                const bool b4 = (lane & 16) != 0;
#pragma unroll
                for (int i = 0; i < 4; ++i) { const float keep = b4 ? d8[i + 4] : d8[i], send = b4 ? d8[i] : d8[i + 4]; d4[i] = keep + __shfl_xor(send, 16); }
                const bool b3 = (lane & 8) != 0;
#pragma unroll
                for (int i = 0; i < 2; ++i) { const float keep = b3 ? d4[i + 2] : d4[i], send = b3 ? d4[i] : d4[i + 2]; d2[i] = keep + __shfl_xor(send, 8); }
                const bool b2 = (lane & 4) != 0;
                { const float keep = b2 ? d2[1] : d2[0], send = b2 ? d2[0] : d2[1]; d1 = keep + __shfl_xor(send, 4); }
                d1 += __shfl_xor(d1, 2);
                d1 += __shfl_xor(d1, 1);
            }
            const float gsh = __shfl(gk, lane >> 2), sush = __shfl(su, lane >> 2), svsh = __shfl(sv, lane >> 2);
            lds_c[h * 64 + lane] = gsh * gelu_t(d1 * sush) * svsh;
            lds_e[h * 64 + lane] = eid;
        }
        lds_fence();
        float outv[16];
#pragma unroll
        for (int i = 0; i < 16; ++i) outv[i] = 0.f;
#pragma unroll 2
        for (int h = 0; h < 8; ++h) {
            const int eh = lds_e[h * 64 + lane];
            const float ch = lds_c[h * 64 + lane];
            u32x4 rr[16];
#pragma unroll
            for (int k = 0; k < 16; ++k) {
                const int ek = __builtin_amdgcn_readlane(eh, k);
                rr[k] = *(const u32x4*)(V + (size_t)ek * 1024 + 16 * lane);
            }
#pragma unroll
            for (int k = 0; k < 16; ++k) {
                const float ck2 = __builtin_bit_cast(float, __builtin_amdgcn_readlane(__builtin_bit_cast(int, ch), 4 * k));
                float f[16];
                unpack16_fp8(rr[k], f);
#pragma unroll
                for (int i = 0; i < 16; ++i) outv[i] += ck2 * f[i];
            }
        }
        float xraw[16];
        {
            const u32x4 r0 = *(const u32x4*)(hf + (size_t)t * 1024 + 16 * lane);
            const u32x4 r1 = *(const u32x4*)(hf + (size_t)t * 1024 + 16 * lane + 8);
            unpack8(r0, xraw); unpack8(r1, xraw + 8);
        }
        float4 x0, x1, x2, x3;
        x0.x = xraw[0] + outv[0]; x0.y = xraw[1] + outv[1]; x0.z = xraw[2] + outv[2]; x0.w = xraw[3] + outv[3];
        x1.x = xraw[4] + outv[4]; x1.y = xraw[5] + outv[5]; x1.z = xraw[6] + outv[6]; x1.w = xraw[7] + outv[7];
        x2.x = xraw[8] + outv[8]; x2.y = xraw[9] + outv[9]; x2.z = xraw[10] + outv[10]; x2.w = xraw[11] + outv[11];
        x3.x = xraw[12] + outv[12]; x3.y = xraw[13] + outv[13]; x3.z = xraw[14] + outv[14]; x3.w = xraw[15] + outv[15];
        if (!dry) {
            if (l + 1 < NL) {
                float ss = x0.x * x0.x + x0.y * x0.y + x0.z * x0.z + x0.w * x0.w + x1.x * x1.x + x1.y * x1.y + x1.z * x1.z + x1.w * x1.w +
                           x2.x * x2.x + x2.y * x2.y + x2.z * x2.z + x2.w * x2.w + x3.x * x3.x + x3.y * x3.y + x3.z * x3.z + x3.w * x3.w;
                ss = wsum(ss);
                u32x4 w0, w1;
                w0.x = pk2(x0.x, x0.y); w0.y = pk2(x0.z, x0.w); w0.z = pk2(x1.x, x1.y); w0.w = pk2(x1.z, x1.w);
                w1.x = pk2(x2.x, x2.y); w1.y = pk2(x2.z, x2.w); w1.z = pk2(x3.x, x3.y); w1.w = pk2(x3.z, x3.w);
                bf16_t* xr = WSP(bf16_t, O_XN) + (size_t)t * 1024 + 16 * lane;
                *(u32x4*)xr = w0;
                *(u32x4*)(xr + 8) = w1;
                if (lane < 8) WSP(float, O_RSS)[(size_t)lane * T + t] = ss * 0.125f;
            } else {
                float4* orow = (float4*)(a.out + (size_t)t * 1024 + 16 * lane);
                orow[0] = x0; orow[1] = x1; orow[2] = x2; orow[3] = x3;
            }
        }
    }
}

#ifndef REP_ID
#define REP_ID -1
#endif
#define REPX(id, dryvar, call) { const int nrp_ = (REP_ID == (id) && l == 0) ? 2 : 1; for (int rp_ = 0; rp_ < nrp_; ++rp_) { const bool dryvar = (nrp_ == 2 && rp_ == 0); (void)dryvar; call; } }
#define STEP_BEGIN { ArgsP ap_ = ap; asm volatile("" : "+s"(ap_)); const Args a = *ap_; if (step >= a.ph_lo && step < a.ph_hi) {
#define STEP_END } ++step; if (step > a.ph_lo && step < a.ph_hi) { if (a.ph_lo < 0) cg::this_grid().sync();   else xcd_barrier((unsigned*)a.ws, xb_xcc_id(), (volatile LAS unsigned*)(LAS unsigned char*)smem + 16384); } }
#if defined(__HIP_DEVICE_COMPILE__)
typedef const __attribute__((address_space(4))) Args* ArgsP;
template <int l>
DEV void layer_steps(ArgsP ap, unsigned char* smem, int& step) {
    STEP_BEGIN
        ph_gemm1(a, l, smem, true);
    STEP_END
    STEP_BEGIN
        REPX(4, dry, ph_cmp1(a, l, smem));
        REPX(3, dry, ph_post(a, l, smem));
    STEP_END
    STEP_BEGIN
        REPX(5, dry, ph_cmp2(a, l));
        REPX(7, dry, ph_sgu(a, l, smem));
        REPX(8, dry, ph_pool(a, l, smem));
    STEP_END
    STEP_BEGIN
        REPX(6, dry, ph_nsa(a, l, smem));
    STEP_END
    STEP_BEGIN
        REPX(9, dry, ph_merge(a, l, smem));
    STEP_END
    STEP_BEGIN
        ph_gemm_resid(a, WSP(bf16_t, O_MERGED), 1024, WSP(bf16_t, O_WOT) + (size_t)l * 1024 * 1024, (const float*)nullptr, smem);
    STEP_END
    STEP_BEGIN
        REPX(12, dry, ph_gemm_bf16(a, WSP(bf16_t, O_XN), WSP(bf16_t, O_XWQT) + (size_t)l * 512 * 1024, WSP(bf16_t, O_XAQ), 512, smem));
    STEP_END
    STEP_BEGIN
        REPX(13, dry, ph_xatt(a, l));
    STEP_END
    STEP_BEGIN
        ph_gemm_resid(a, WSP(bf16_t, O_XAO), 512, WSP(bf16_t, O_XWOT) + (size_t)l * 1024 * 512, (const float*)nullptr, smem);
    STEP_END
    STEP_BEGIN
        REPX(14, dry, ph_gemm_bf16(a, WSP(bf16_t, O_XN), WSP(bf16_t, O_PWQT) + (size_t)l * 1024 * 1024, WSP(bf16_t, O_PQ), 1024, smem));
    STEP_END
    STEP_BEGIN
        REPX(15, dry, ph_ptop(a, l, smem));
    STEP_END
    STEP_BEGIN
        REPX(16, dry, ph_pexp(a, l, dry, smem));
    STEP_END
}
#endif
__global__ void __launch_bounds__(256, 2) fwd_kernel(Args a_by_value) {
#if defined(__HIP_DEVICE_COMPILE__)
    ArgsP ap = (ArgsP)__builtin_amdgcn_kernarg_segment_ptr();
    extern __shared__ __attribute__((aligned(16))) unsigned char smem[];
    if (threadIdx.x < 4) ((volatile LAS unsigned*)(LAS unsigned char*)smem)[16384 + threadIdx.x] = 0u;
    __syncthreads();
    if (ap->ph_hi - ap->ph_lo > 1) (void)xcd_barrier_post((unsigned*)ap->ws, (volatile LAS unsigned*)(LAS unsigned char*)smem + 16384);
    int step = 0;
    STEP_BEGIN
        ph_prep(a, smem);
        ph_mem1(a);
        x_to_bf16_rss(a.in[I_X], WSP(bf16_t, O_XN), WSP(float, O_RSS), T);
    STEP_END
    STEP_BEGIN
        ph_mem2(a, smem);
    STEP_END
    STEP_BEGIN
        ph_mem3(a);
    STEP_END
    layer_steps<0>(ap, smem, step);
    layer_steps<1>(ap, smem, step);
#endif
}
constexpr int N_STEPS = 3 + 12 + 12;
constexpr int LDS_DYN = 65536 + 64;

extern "C" void kernel_launch(void* const* d_in, const int* in_sizes, int n_in, void* d_out, int out_size, void* d_ws, size_t ws_size,
                              hipStream_t stream) {
    static int grid_blocks = 0;
    if (!grid_blocks) {
        int dev = 0, cus = 0, per_cu = 0;
        hipGetDevice(&dev);
        hipDeviceGetAttribute(&cus, hipDeviceAttributeMultiprocessorCount, dev);
        hipFuncSetAttribute((const void*)fwd_kernel, hipFuncAttributeMaxDynamicSharedMemorySize, LDS_DYN);
        hipOccupancyMaxActiveBlocksPerMultiprocessor(&per_cu, fwd_kernel, 256, LDS_DYN);
        if (per_cu > 2) per_cu = 2;
        if (per_cu < 1) per_cu = 1;
        grid_blocks = cus * per_cu;
    }
    if (ws_size < WS_NEED) { fprintf(stderr, "workspace too small: %zu < %zu\n", ws_size, (size_t)WS_NEED); return; }
    Args a{};
    for (int i = 0; i < N_IN; ++i) a.in[i] = (const float*)d_in[i];
    a.out = (float*)d_out;
    a.ws = (unsigned char*)d_ws;
#if MEGA
    a.ph_lo = 0; a.ph_hi = N_STEPS;
    void* args[] = {&a};
    (void)hipMemsetAsync(d_ws, 0, 16384, stream);
    hipError_t e = hipLaunchCooperativeKernel((void*)fwd_kernel, dim3(grid_blocks), dim3(256), args, LDS_DYN, stream);
    if (e != hipSuccess) fprintf(stderr, "cooperative launch failed: %s (grid %d)\n", hipGetErrorString(e), grid_blocks);
#else
    for (int s = 0; s < N_STEPS; ++s) {
        a.ph_lo = s; a.ph_hi = s + 1;
        fwd_kernel<<<dim3(grid_blocks), dim3(256), LDS_DYN, stream>>>(a);
    }
#endif
}
```

```cpp
#include <hip/hip_runtime.h>
#include <hip/hip_cooperative_groups.h>
#include <stdint.h>
#include <stdio.h>
namespace cg = cooperative_groups;

#ifndef MEGA
#define MEGA 1
#endif

#ifndef REP_ID
#define REP_ID -1
#endif
#define DEV __device__ __forceinline__
typedef unsigned short bf16_t;
typedef __attribute__((ext_vector_type(8))) short bf16x8;
typedef __attribute__((ext_vector_type(2))) float f32x2;
typedef __attribute__((ext_vector_type(4))) float f32x4;
typedef __attribute__((ext_vector_type(16))) float f32x16;
typedef __attribute__((ext_vector_type(4))) unsigned u32x4;
typedef __attribute__((ext_vector_type(2))) unsigned u32x2;

constexpr int NB = 2, S = 16384, T = NB * S, D = 1024, NL = 2;
constexpr int NZ = 2072, INW = 5144;
constexpr int ZKV = 512, ZG = 1280, ZSGU = 1304, ZPOOL = 1816;
constexpr float EPS = 1e-6f;
constexpr float LOG2E = 1.4426950408889634f;

enum { I_X = 0, I_MEM, I_MIXN, I_WIN, I_QN, I_KN, I_PE, I_W1, I_W2, I_LNG, I_LNB, I_SGUW, I_SGUB, I_POOLW, I_POOLS,
       I_LA, I_LB, I_LC, I_WOUT, I_XAN, I_MEMN, I_XWQ, I_XWK, I_XWV, I_XQN, I_XKN, I_XWO, I_FFN, I_PWQ, I_K1, I_K2, I_PU, I_PV, N_IN };

constexpr size_t MiB = 1ull << 20;
constexpr size_t O_WINT = 1 * MiB;
constexpr size_t O_LAT = 22 * MiB;
constexpr size_t O_LBT = 24 * MiB;
constexpr size_t O_LCT = 25 * MiB;
constexpr size_t O_WOT = 26 * MiB;
constexpr size_t O_XWQT = 30 * MiB;
constexpr size_t O_XWKT = 32 * MiB;
constexpr size_t O_XWVT = 34 * MiB;
constexpr size_t O_XWOT = 36 * MiB;
constexpr size_t O_PWQT = 38 * MiB;
constexpr size_t O_W1T = 42 * MiB;
constexpr size_t O_POOLT = 44 * MiB;
constexpr size_t O_SGUW = O_POOLT + 65536;
constexpr size_t O_KEYS = O_SGUW + 262144;
constexpr size_t O_PW1 = O_KEYS + 65536;
constexpr size_t O_MEMH = 45 * MiB;
constexpr size_t O_XKVT = 47 * MiB;
constexpr size_t O_XK = 51 * MiB;
constexpr size_t O_XVT = 52 * MiB;
constexpr size_t O_HID = 53 * MiB;
constexpr size_t O_KC = 55 * MiB;
constexpr size_t O_VCT = O_KC + 524288;
constexpr size_t O_GATE = 56 * MiB;
constexpr size_t O_XN = 60 * MiB;
constexpr size_t O_ZBUF = 124 * MiB;
constexpr size_t O_MERGED = O_ZBUF;
constexpr size_t O_PQ = O_ZBUF + 64 * MiB;
constexpr size_t O_QN = 254 * MiB;
constexpr size_t O_XAQ = O_QN;
constexpr size_t O_KSLC = 286 * MiB;
constexpr size_t O_KWIN = 294 * MiB;
constexpr size_t O_VSLCT = 302 * MiB;
constexpr size_t O_VWINT = 310 * MiB;
constexpr size_t O_UG = 318 * MiB;
constexpr size_t O_VLN = 334 * MiB;
constexpr size_t O_DPOOL = 350 * MiB;
constexpr size_t O_PTOP = O_UG;
constexpr size_t O_OA = 366 * MiB;
constexpr size_t O_XAO = O_OA;
constexpr size_t O_OB = 398 * MiB;
constexpr size_t O_OC = 414 * MiB;
constexpr size_t O_PU = 430 * MiB;
constexpr size_t O_PVB = 446 * MiB;
constexpr size_t O_PSC = 462 * MiB;
constexpr size_t O_RSS = 463 * MiB;
constexpr size_t WS_NEED = 464 * MiB;

struct Args {
    const float* in[N_IN];
    float* out;
    unsigned char* ws;
    int ph_lo, ph_hi;
};

DEV float bflo(unsigned w) { return __uint_as_float(w << 16); }
DEV float bfhi(unsigned w) { return __uint_as_float(w & 0xffff0000u); }
DEV unsigned pk2(float lo, float hi);
DEV unsigned f2bf(float f) { return pk2(f, 0.f) & 0xffffu; }
typedef __attribute__((ext_vector_type(2))) __bf16 bf16x2v;
DEV unsigned pk2(float lo, float hi) { f32x2 v = {lo, hi}; return __builtin_bit_cast(unsigned, __builtin_convertvector(v, bf16x2v)); }
template <int CTRL> DEV int dpp_i(int v) { return __builtin_amdgcn_update_dpp(v, v, CTRL, 0xF, 0xF, false); }
template <int CTRL> DEV float dpp_f(float v) { return __builtin_bit_cast(float, dpp_i<CTRL>(__builtin_bit_cast(int, v))); }
DEV float sum4(float v) { v += dpp_f<0xB1>(v); v += dpp_f<0x4E>(v); return v; }
DEV float sum8(float v) { v = sum4(v); v += dpp_f<0x141>(v); return v; }
DEV float sum16(float v) { v = sum8(v); v += dpp_f<0x140>(v); return v; }
DEV unsigned max4u(unsigned v) { v = max(v, (unsigned)dpp_i<0xB1>((int)v)); v = max(v, (unsigned)dpp_i<0x4E>((int)v)); return v; }
DEV unsigned max16u(unsigned v) { v = max4u(v); v = max(v, (unsigned)dpp_i<0x141>((int)v)); v = max(v, (unsigned)dpp_i<0x140>((int)v)); return v; }
DEV float wsum(float v) {
#pragma unroll
    for (int o = 32; o >= 1; o >>= 1) v += __shfl_xor(v, o);
    return v;
}
DEV float wmaxf(float v) {
#pragma unroll
    for (int o = 32; o >= 1; o >>= 1) v = fmaxf(v, __shfl_xor(v, o));
    return v;
}
DEV float gelu_t(float x) {
    float u = 0.7978845608028654f * (x + 0.044715f * x * x * x);
    return x / (1.f + __expf(-2.f * u));
}
DEV float fexp2(float x) { return __builtin_amdgcn_exp2f(x); }
DEV float sigmoidf_(float x) { return 1.f / (1.f + __expf(-x)); }
DEV unsigned f2sort(float f) { unsigned u = __float_as_uint(f); return (u & 0x80000000u) ? ~u : (u | 0x80000000u); }
DEV float sort2f(unsigned s) { unsigned u = (s & 0x80000000u) ? (s & 0x7fffffffu) : ~s; return __uint_as_float(u); }
DEV void unpack8(u32x4 r, float* f) {
    f[0] = bflo(r.x); f[1] = bfhi(r.x); f[2] = bflo(r.y); f[3] = bfhi(r.y);
    f[4] = bflo(r.z); f[5] = bfhi(r.z); f[6] = bflo(r.w); f[7] = bfhi(r.w);
}
DEV f32x4 mfma16(bf16x8 a, bf16x8 b, f32x4 c) { return __builtin_amdgcn_mfma_f32_16x16x32_bf16(a, b, c, 0, 0, 0); }
DEV f32x16 mfma32(bf16x8 a, bf16x8 b, f32x16 c) { return __builtin_amdgcn_mfma_f32_32x32x16_bf16(a, b, c, 0, 0, 0); }
DEV bf16x8 ld8(const bf16_t* p) { return *(const bf16x8*)p; }
DEV void lds_fence() { asm volatile("s_waitcnt lgkmcnt(0)" ::: "memory"); }

DEV void transpose_cvt(unsigned char* smem, int& rot, const float* __restrict__ W, int K, int N, bf16_t* __restrict__ WT, int ldt, const float* __restrict__ gk = nullptr) {
    float* tile = (float*)smem;
    const int tk = (K + 63) / 64, tn = (N + 63) / 64;
    const int G = gridDim.x;
    int first = ((int)blockIdx.x - rot % G + G) % G;
    rot += tk * tn;
    for (int it = first; it < tk * tn; it += G) {
        const int k0 = (it / tn) * 64, n0 = (it % tn) * 64;
        __syncthreads();
#pragma unroll
        for (int p = 0; p < 4; ++p) {
            const int k = p * 16 + (threadIdx.x >> 4), n = (threadIdx.x & 15) * 4;
            float4 v = make_float4(0.f, 0.f, 0.f, 0.f);
            if (k0 + k < K && n0 + n < N) {
                v = *(const float4*)(W + (size_t)(k0 + k) * N + n0 + n);
                if (gk) { const float g = gk[k0 + k]; v.x *= g; v.y *= g; v.z *= g; v.w *= g; }
            }
            float* tp = tile + k * 65 + n;
            tp[0] = v.x; tp[1] = v.y; tp[2] = v.z; tp[3] = v.w;
        }
        __syncthreads();
#pragma unroll
        for (int p = 0; p < 2; ++p) {
            const int n = p * 32 + (threadIdx.x >> 3), k = (threadIdx.x & 7) * 8;
            if (k0 + k < K && n0 + n < N) {
                const float* tp = tile + k * 65 + n;
                u32x4 w;
                w.x = pk2(tp[0], tp[65]); w.y = pk2(tp[130], tp[195]); w.z = pk2(tp[260], tp[325]); w.w = pk2(tp[390], tp[455]);
                *(u32x4*)(WT + (size_t)(n0 + n) * ldt + k0 + k) = w;
            }
        }
    }
}

DEV void rmsnorm_rows(const float* __restrict__ X, const float* __restrict__ g, bf16_t* __restrict__ Y, int rows) {
    const int wave = threadIdx.x >> 6, lane = threadIdx.x & 63;
    for (int r = blockIdx.x * 4 + wave; r < rows; r += gridDim.x * 4) {
        const float4* xr = (const float4*)(X + (size_t)r * 1024);
        float4 v[4];
        float ss = 0.f;
#pragma unroll
        for (int i = 0; i < 4; ++i) { v[i] = xr[lane + 64 * i]; ss += v[i].x * v[i].x + v[i].y * v[i].y + v[i].z * v[i].z + v[i].w * v[i].w; }
        ss = wsum(ss);
        const float rs = rsqrtf(ss * (1.f / 1024.f) + EPS);
#pragma unroll
        for (int i = 0; i < 4; ++i) {
            const float4 gg = ((const float4*)g)[lane + 64 * i];
            u32x2 o;
            o.x = pk2(v[i].x * rs * gg.x, v[i].y * rs * gg.y);
            o.y = pk2(v[i].z * rs * gg.z, v[i].w * rs * gg.w);
            *(u32x2*)(Y + (size_t)r * 1024 + (lane + 64 * i) * 4) = o;
        }
    }
}

DEV void x_to_bf16_rss(const float* __restrict__ X, bf16_t* __restrict__ Y, float* __restrict__ rsp, int rows) {
    const int wave = threadIdx.x >> 6, lane = threadIdx.x & 63;
    for (int r = blockIdx.x * 4 + wave; r < rows; r += gridDim.x * 4) {
        const float4* xr = (const float4*)(X + (size_t)r * 1024);
        float4 v[4];
        float ss = 0.f;
#pragma unroll
        for (int i = 0; i < 4; ++i) { v[i] = xr[lane + 64 * i]; ss += v[i].x * v[i].x + v[i].y * v[i].y + v[i].z * v[i].z + v[i].w * v[i].w; }
        ss = wsum(ss);
#pragma unroll
        for (int i = 0; i < 4; ++i) {
            u32x2 o;
            o.x = pk2(v[i].x, v[i].y);
            o.y = pk2(v[i].z, v[i].w);
            *(u32x2*)(Y + (size_t)r * 1024 + (lane + 64 * i) * 4) = o;
        }
        if (lane < 8) rsp[(size_t)lane * T + r] = ss * 0.125f;
    }
}

template <int MI, int NI, bool BKN, class AF, class BF>
DEV void gemm_kloop_rs(unsigned char* smem, int K, AF arow, BF brow, f32x16 (&acc)[MI][NI]) {
    constexpr int BM = 64 * MI, BN = 64 * NI;
    constexpr int LA = BM / 32, LB = BN / 32;
    bf16_t* As = (bf16_t*)smem;
    bf16_t* Bs = As + BM * 72;
    const int tid = threadIdx.x, lane = tid & 63, wave = tid >> 6, wm = wave >> 1, wn = wave & 1;
    const int lr = tid >> 3, ls = (tid & 7) * 8;
    u32x4 ra[LA], rb[LB];
#pragma unroll
    for (int i = 0; i < LA; ++i) ra[i] = *(const u32x4*)(arow(lr + 32 * i, 0) + ls);
#pragma unroll
    for (int i = 0; i < LB; ++i) rb[i] = *(const u32x4*)(brow(lr + 32 * i, 0) + ls);
    for (int k0 = 0; k0 < K; k0 += 64) {
        __syncthreads();
#pragma unroll
        for (int i = 0; i < LA; ++i) *(u32x4*)(As + (lr + 32 * i) * 72 + ls) = ra[i];
        if (!BKN) {
#pragma unroll
            for (int i = 0; i < LB; ++i) *(u32x4*)(Bs + (lr + 32 * i) * 72 + ls) = rb[i];
        } else {
#pragma unroll
            for (int i = 0; i < LB; ++i) {
                const int kl = lr + 32 * i;
                const unsigned w[4] = {rb[i].x, rb[i].y, rb[i].z, rb[i].w};
#pragma unroll
                for (int e = 0; e < 4; ++e) {
                    Bs[(ls + 2 * e) * 72 + kl] = (bf16_t)(w[e] & 0xffffu);
                    Bs[(ls + 2 * e + 1) * 72 + kl] = (bf16_t)(w[e] >> 16);
                }
            }
        }
        __syncthreads();
        if (k0 + 64 < K) {
#pragma unroll
            for (int i = 0; i < LA; ++i) ra[i] = *(const u32x4*)(arow(lr + 32 * i, k0 + 64) + ls);
#pragma unroll
            for (int i = 0; i < LB; ++i) rb[i] = *(const u32x4*)(brow(lr + 32 * i, k0 + 64) + ls);
        }
#pragma unroll
        for (int kk = 0; kk < 4; ++kk) {
            bf16x8 af[MI], bfr[NI];
#pragma unroll
            for (int mi = 0; mi < MI; ++mi) af[mi] = ld8(As + (wm * 32 * MI + mi * 32 + (lane & 31)) * 72 + kk * 16 + (lane >> 5) * 8);
#pragma unroll
            for (int ni = 0; ni < NI; ++ni) bfr[ni] = ld8(Bs + (wn * 32 * NI + ni * 32 + (lane & 31)) * 72 + kk * 16 + (lane >> 5) * 8);
#pragma unroll
            for (int mi = 0; mi < MI; ++mi)
#pragma unroll
                for (int ni = 0; ni < NI; ++ni) acc[mi][ni] = mfma32(af[mi], bfr[ni], acc[mi][ni]);
        }
    }
}
template <int MI, int NI>
DEV void acc_zero_rs(f32x16 (&acc)[MI][NI]) {
#pragma unroll
    for (int mi = 0; mi < MI; ++mi)
#pragma unroll
        for (int ni = 0; ni < NI; ++ni)
#pragma unroll
            for (int r = 0; r < 16; ++r) acc[mi][ni][r] = 0.f;
}
template <int MI, int NI, class EF>
DEV void gemm_epi_rs(f32x16 (&acc)[MI][NI], EF epi) {
    const int lane = threadIdx.x & 63, wave = threadIdx.x >> 6, wm = wave >> 1, wn = wave & 1;
#pragma unroll
    for (int mi = 0; mi < MI; ++mi)
#pragma unroll
        for (int ni = 0; ni < NI; ++ni)
#pragma unroll
            for (int r = 0; r < 16; ++r) {
                const int row = wm * 32 * MI + mi * 32 + (r & 3) + 8 * (r >> 2) + 4 * (lane >> 5);
                const int col = wn * 32 * NI + ni * 32 + (lane & 31);
                epi(row, col, acc[mi][ni][r]);
            }
}


#define LAS_ __attribute__((address_space(3)))
#define GAS_ __attribute__((address_space(1)))
DEV void glds16(const void* g, void* l) { __builtin_amdgcn_global_load_lds((const GAS_ unsigned*)g, (LAS_ unsigned*)l, 16, 0, 0); }
DEV void stage_rc(int b, int& R, int& C) {
    const int st = b >> 10, sb = b & 1023, swz = sb ^ (((sb >> 9) & 1) << 5);
    R = (st >> 1) * 16 + (swz >> 6);
    C = (st & 1) * 32 + ((swz & 63) >> 1);
}
template <int FM, int FN, class AF, class BF>
DEV void gemm_kloop(unsigned char* smem, int K, AF arow, BF brow, f32x4 (&acc)[FM][FN]) {
    constexpr int BM = 32 * FM, BN = 32 * FN, ABYTES = BM * 128, BBYTES = BN * 128, BUF = ABYTES + BBYTES;
    int tid = threadIdx.x;
    asm volatile("" : "+v"(tid));
    const int lane = tid & 63, wave = tid >> 6, wm = wave >> 1, wn = wave & 1, fr = lane & 15, fq = lane >> 4;
    const int lofs = (fr * 64 + fq * 16) ^ ((fr >> 3) << 5);
    auto stage = [&](int buf, int k0) {
        unsigned char* As = smem + buf * BUF;
        unsigned char* Bs = As + ABYTES;
#pragma unroll
        for (int i = 0; i < BM / 32; ++i) { const int b = tid * 16 + i * 4096; int R, C; stage_rc(b, R, C); glds16(arow(R, k0) + C, As + b); }
#pragma unroll
        for (int i = 0; i < BN / 32; ++i) { const int b = tid * 16 + i * 4096; int R, C; stage_rc(b, R, C); glds16(brow(R, k0) + C, Bs + b); }
    };
    __syncthreads();
    stage(0, 0);
    asm volatile("s_waitcnt vmcnt(0)" ::: "memory");
    __syncthreads();
    const int nt = K >> 6;
    for (int t = 0; t < nt; ++t) {
        if (t + 1 < nt) stage((t + 1) & 1, (t + 1) * 64);
        const unsigned char* As = smem + (t & 1) * BUF + (wm * FM) * 2048 + lofs;
        const unsigned char* Bs = smem + (t & 1) * BUF + ABYTES + (wn * FN) * 2048 + lofs;
#pragma unroll
        for (int k = 0; k < 2; ++k) {
            bf16x8 af[FM], bfr[FN];
#pragma unroll
            for (int m = 0; m < FM; ++m) af[m] = *(const bf16x8*)(As + (m * 2 + k) * 1024);
#pragma unroll
            for (int n = 0; n < FN; ++n) bfr[n] = *(const bf16x8*)(Bs + (n * 2 + k) * 1024);
#pragma unroll
            for (int m = 0; m < FM; ++m)
#pragma unroll
                for (int n = 0; n < FN; ++n) acc[m][n] = mfma16(af[m], bfr[n], acc[m][n]);
        }
        __builtin_amdgcn_sched_barrier(0);
        asm volatile("s_waitcnt vmcnt(0)" ::: "memory");
        __syncthreads();
    }
}
template <int FM, int FN>
DEV void acc_zero(f32x4 (&acc)[FM][FN]) {
#pragma unroll
    for (int m = 0; m < FM; ++m)
#pragma unroll
        for (int n = 0; n < FN; ++n) acc[m][n] = (f32x4){0.f, 0.f, 0.f, 0.f};
}
template <int FM, int FN, class EF>
DEV void gemm_epi(f32x4 (&acc)[FM][FN], EF epi) {
    const int lane = threadIdx.x & 63, wave = threadIdx.x >> 6, wm = wave >> 1, wn = wave & 1, fr = lane & 15, fq = lane >> 4;
#pragma unroll
    for (int m = 0; m < FM; ++m)
#pragma unroll
        for (int n = 0; n < FN; ++n)
#pragma unroll
            for (int j = 0; j < 4; ++j) epi(wm * 16 * FM + m * 16 + fq * 4 + j, wn * 16 * FN + n * 16 + fr, acc[m][n][j]);
}

struct TileIter {
    int lt, lstep, ltot, x, nt_n; bool xm;
    DEV TileIter(int n_mt, int n_nt) {
        xm = ((gridDim.x & 7) == 0) && ((n_mt & 7) == 0);
        nt_n = n_nt;
        if (xm) { x = blockIdx.x & 7; lt = blockIdx.x >> 3; lstep = gridDim.x >> 3; ltot = (n_mt >> 3) * n_nt; }
        else { x = 0; lt = blockIdx.x; lstep = gridDim.x; ltot = n_mt * n_nt; }
    }
    DEV bool valid() const { return lt < ltot; }
    DEV void next() { lt += lstep; }
    DEV int mt() const { return xm ? ((lt / nt_n) * 8 + x) : (lt / nt_n); }
    DEV int nt() const { return lt % nt_n; }
};

template <int FM, int FN, class AF, class BF>
DEV void gemm_kloop32(unsigned char* smem, int K, AF arow, BF brow, f32x4 (&acc)[FM][FN]) {
    constexpr int BM = 32 * FM, BN = 32 * FN, ABYTES = BM * 64, BBYTES = BN * 64, BUF = ABYTES + BBYTES;
    static_assert(ABYTES % 4096 == 0 && BBYTES % 1024 == 0, "A rows must be a multiple of 64, B rows a multiple of 16");
    int tid = threadIdx.x;
    asm volatile("" : "+v"(tid));
    const int lane = tid & 63, wave = tid >> 6, wm = wave >> 1, wn = wave & 1, fr = lane & 15, fq = lane >> 4;
    const int lofs = (fr * 64 + fq * 16) ^ ((fr >> 3) << 5);
    auto stage = [&](int buf, int k0) {
        unsigned char* As = smem + buf * BUF;
        unsigned char* Bs = As + ABYTES;
#pragma unroll
        for (int i = 0; i < ABYTES / 4096; ++i) {
            const int b = tid * 16 + i * 4096, sb = b & 1023, swz = sb ^ (((sb >> 9) & 1) << 5);
            glds16(arow((b >> 10) * 16 + (swz >> 6), k0) + ((swz & 63) >> 1), As + b);
        }
#pragma unroll
        for (int i = 0; i < (BBYTES + 4095) / 4096; ++i) {
            const int b = tid * 16 + i * 4096, sb = b & 1023, swz = sb ^ (((sb >> 9) & 1) << 5);
            if ((BBYTES % 4096) == 0 || b < BBYTES)
                glds16(brow((b >> 10) * 16 + (swz >> 6), k0) + ((swz & 63) >> 1), Bs + b);
        }
    };
    __syncthreads();
    stage(0, 0);
    asm volatile("s_waitcnt vmcnt(0)" ::: "memory");
    __syncthreads();
    const int nt = K >> 5;
    for (int t = 0; t < nt; ++t) {
        if (t + 1 < nt) stage((t + 1) & 1, (t + 1) * 32);
        const unsigned char* As = smem + (t & 1) * BUF + (wm * FM) * 1024 + lofs;
        const unsigned char* Bs = smem + (t & 1) * BUF + ABYTES + (wn * FN) * 1024 + lofs;
        bf16x8 af[FM];
#pragma unroll
        for (int m = 0; m < FM; ++m) af[m] = *(const bf16x8*)(As + m * 1024);
        constexpr int NH = (FN % 3 == 0 && FN > 6) ? 3 : ((FN > 4) ? 2 : 1), FNH = FN / NH;
        static_assert(FNH * NH == FN, "FN must split evenly");
#pragma unroll
        for (int hh = 0; hh < NH; ++hh) {
            bf16x8 bfr[FNH];
#pragma unroll
            for (int n = 0; n < FNH; ++n) bfr[n] = *(const bf16x8*)(Bs + (hh * FNH + n) * 1024);
#pragma unroll
            for (int m = 0; m < FM; ++m)
#pragma unroll
                for (int n = 0; n < FNH; ++n) acc[m][hh * FNH + n] = mfma16(af[m], bfr[n], acc[m][hh * FNH + n]);
        }
        __builtin_amdgcn_sched_barrier(0);
        asm volatile("s_waitcnt vmcnt(0)" ::: "memory");
        __syncthreads();
    }
}

template <int FM, int FN, int G0, int G1, int G2, class AF, class BF>
DEV void gemm_kloop_seg3(unsigned char* smem, AF arow, BF brow, f32x4 (&acc0)[FM][FN], f32x4 (&acc1)[FM][FN], f32x4 (&acc2)[FM][FN]) {
    constexpr int BM = 32 * FM, BN = 32 * FN, ABYTES = BM * 128, BBYTES = BN * 128, BUF = ABYTES + BBYTES, NT = G0 + G1 + G2;
    int tid = threadIdx.x;
    asm volatile("" : "+v"(tid));
    const int lane = tid & 63, wave = tid >> 6, wm = wave >> 1, wn = wave & 1, fr = lane & 15, fq = lane >> 4;
    const int lofs = (fr * 64 + fq * 16) ^ ((fr >> 3) << 5);
    auto stage = [&](int buf, int g) {
        unsigned char* As = smem + buf * BUF;
        unsigned char* Bs = As + ABYTES;
#pragma unroll
        for (int i = 0; i < BM / 32; ++i) { const int b = tid * 16 + i * 4096; int R, C; stage_rc(b, R, C); glds16(arow(R, g) + C, As + b); }
#pragma unroll
        for (int i = 0; i < BN / 32; ++i) { const int b = tid * 16 + i * 4096; int R, C; stage_rc(b, R, C); glds16(brow(R, g) + C, Bs + b); }
    };
    __syncthreads();
    stage(0, 0);
    asm volatile("s_waitcnt vmcnt(0)" ::: "memory");
    __syncthreads();
    for (int t = 0; t < NT; ++t) {
        if (t + 1 < NT) stage((t + 1) & 1, t + 1);
        const unsigned char* As = smem + (t & 1) * BUF + (wm * FM) * 2048 + lofs;
        const unsigned char* Bs = smem + (t & 1) * BUF + ABYTES + (wn * FN) * 2048 + lofs;
#pragma unroll
        for (int k = 0; k < 2; ++k) {
            bf16x8 af[FM], bfr[FN];
#pragma unroll
            for (int m = 0; m < FM; ++m) af[m] = *(const bf16x8*)(As + (m * 2 + k) * 1024);
#pragma unroll
            for (int n = 0; n < FN; ++n) bfr[n] = *(const bf16x8*)(Bs + (n * 2 + k) * 1024);
            if (t < G0) {
#pragma unroll
                for (int m = 0; m < FM; ++m)
#pragma unroll
                    for (int n = 0; n < FN; ++n) acc0[m][n] = mfma16(af[m], bfr[n], acc0[m][n]);
            } else if (t < G0 + G1) {
#pragma unroll
                for (int m = 0; m < FM; ++m)
#pragma unroll
                    for (int n = 0; n < FN; ++n) acc1[m][n] = mfma16(af[m], bfr[n], acc1[m][n]);
            } else {
#pragma unroll
                for (int m = 0; m < FM; ++m)
#pragma unroll
                    for (int n = 0; n < FN; ++n) acc2[m][n] = mfma16(af[m], bfr[n], acc2[m][n]);
            }
        }
        __builtin_amdgcn_sched_barrier(0);
        asm volatile("s_waitcnt vmcnt(0)" ::: "memory");
        __syncthreads();
    }
}

#define LAS __attribute__((address_space(3)))
#define XB_TMO      128
#define XB_XCNT(j)  (256  + 64 * (j))
#define XB_XSUB(j)  (1280 + 64 * (j))
#define XB_XGEN(j)  (2304 + 64 * (j))
#define XB_TOP      3328
#define XB_TOPGEN   3392
#define XCD_BAR_WORDS 3456
#define XB_SPIN_CAP (1u << 25)
DEV unsigned xb_ld(unsigned* p) { return __hip_atomic_load(p, __ATOMIC_RELAXED, __HIP_MEMORY_SCOPE_AGENT); }
DEV unsigned xb_add(unsigned* p, unsigned v) { return __hip_atomic_fetch_add(p, v, __ATOMIC_RELAXED, __HIP_MEMORY_SCOPE_AGENT); }
DEV unsigned xb_xcc_id() { return (unsigned)__builtin_amdgcn_s_getreg((3 << 11) | 20) & 0xFu; }
#define XB_SPIN(cond, bar) do { unsigned _sp = 0; while (cond) { __builtin_amdgcn_s_sleep(1); \
    if ((++_sp & 255u) == 0u) { if (xb_ld(&(bar)[XB_TMO])) break; if (_sp > XB_SPIN_CAP) { atomicAdd(&(bar)[XB_TMO], 1u); break; } } } } while (0)
struct XcdBarrier { unsigned* bar; unsigned x; volatile LAS unsigned* st; };
DEV XcdBarrier xcd_barrier_post(unsigned* bar, volatile LAS unsigned* st) {
    XcdBarrier b; b.bar = bar; b.x = xb_xcc_id(); b.st = st;
    if (threadIdx.x == 0) (void)xb_add(&bar[XB_XCNT(b.x)], 1u);
    return b;
}
DEV void xcd_barrier_complete(unsigned* bar, unsigned x, unsigned& nloc, unsigned& nx) {
    const unsigned G = gridDim.x * gridDim.y * gridDim.z;
    unsigned sum, cnt, mine, sp = 0u;
    for (;;) {
        sum = 0u; cnt = 0u; mine = 0u;
#pragma unroll
        for (unsigned j = 0; j < 16; ++j) { const unsigned c = xb_ld(&bar[XB_XCNT(j)]); sum += c; cnt += (c > 0u) ? 1u : 0u; mine = (j == x) ? c : mine; }
        if (sum == G) break;
        __builtin_amdgcn_s_sleep(1);
        if ((++sp & 255u) == 0u) { if (xb_ld(&bar[XB_TMO])) break; if (sp > XB_SPIN_CAP) { atomicAdd(&bar[XB_TMO], 1u); break; } }
    }
    nloc = mine > 0u ? mine : 1u; nx = cnt > 0u ? cnt : 1u;
}
DEV void xcd_barrier(unsigned* bar_, unsigned bx_, volatile LAS unsigned* st_) {
    XcdBarrier b; b.bar = bar_; b.x = bx_; b.st = st_;
    asm volatile("s_waitcnt vmcnt(0)" ::: "memory");
    __syncthreads();
    if (threadIdx.x == 0) {
        unsigned* bar = b.bar;
        __builtin_amdgcn_s_waitcnt(0);
        unsigned nloc = b.st[0], nx = b.st[1];
        if (nloc == 0u) { xcd_barrier_complete(bar, b.x, nloc, nx); b.st[0] = nloc; b.st[1] = nx; }
        const unsigned old = xb_add(&bar[XB_XSUB(b.x)], 1u);
        const unsigned gen = old / nloc;
        if (old + 1u == (gen + 1u) * nloc) {
            __builtin_amdgcn_fence(__ATOMIC_RELEASE, "agent");
            asm volatile("s_waitcnt vmcnt(0)" ::: "memory");
            const unsigned og = xb_add(&bar[XB_TOP], 1u);
            const unsigned tg = og / nx;
            if (og + 1u == (tg + 1u) * nx) xb_add(&bar[XB_TOPGEN], 1u);
            else XB_SPIN(xb_ld(&bar[XB_TOPGEN]) == tg, bar);
            __builtin_amdgcn_fence(__ATOMIC_ACQUIRE, "agent");
            xb_add(&bar[XB_XGEN(b.x)], 1u);
            asm volatile("s_waitcnt vmcnt(0)" ::: "memory");
        } else {
            XB_SPIN(xb_ld(&bar[XB_XGEN(b.x)]) == gen, bar);
            __builtin_amdgcn_fence(__ATOMIC_ACQUIRE, "agent");
            asm volatile("s_waitcnt vmcnt(0)" ::: "memory");
        }
    }
    __syncthreads();
}

#define WSP(T_, off) ((T_*)(a.ws + (off)))
DEV float row_rstd(const float* rsp, int row) {
    float s = 0.f;
#pragma unroll
    for (int i = 0; i < 8; ++i) s += rsp[(size_t)i * T + row];
    return rsqrtf(s * (1.f / 1024.f) + EPS);
}

DEV void ph_prep(const Args& a, unsigned char* smem) {
    int rot = 0;
    for (int l = 0; l < NL; ++l) {
        transpose_cvt(smem, rot, a.in[I_WIN] + (size_t)l * 1024 * INW, 1024, INW, WSP(bf16_t, O_WINT) + (size_t)l * INW * 1024, 1024, a.in[I_MIXN] + l * 1024);
        transpose_cvt(smem, rot, a.in[I_LA] + (size_t)l * 512 * 1024, 512, 1024, WSP(bf16_t, O_LAT) + (size_t)l * 1024 * 1024, 1024);
        transpose_cvt(smem, rot, a.in[I_LB] + (size_t)l * 256 * 1024, 256, 1024, WSP(bf16_t, O_LAT) + (size_t)l * 1024 * 1024 + 512, 1024);
        transpose_cvt(smem, rot, a.in[I_LC] + (size_t)l * 256 * 1024, 256, 1024, WSP(bf16_t, O_LAT) + (size_t)l * 1024 * 1024 + 768, 1024);
        transpose_cvt(smem, rot, a.in[I_WOUT] + (size_t)l * 1024 * 1024, 1024, 1024, WSP(bf16_t, O_WOT) + (size_t)l * 1024 * 1024, 1024);
        transpose_cvt(smem, rot, a.in[I_XWQ] + (size_t)l * 1024 * 512, 1024, 512, WSP(bf16_t, O_XWQT) + (size_t)l * 512 * 1024, 1024, a.in[I_XAN] + l * 1024);
        transpose_cvt(smem, rot, a.in[I_XWK] + (size_t)l * 1024 * 512, 1024, 512, WSP(bf16_t, O_XWKT) + (size_t)l * 512 * 1024, 1024);
        transpose_cvt(smem, rot, a.in[I_XWV] + (size_t)l * 1024 * 512, 1024, 512, WSP(bf16_t, O_XWVT) + (size_t)l * 512 * 1024, 1024);
        transpose_cvt(smem, rot, a.in[I_XWO] + (size_t)l * 512 * 1024, 512, 1024, WSP(bf16_t, O_XWOT) + (size_t)l * 1024 * 512, 512);
        transpose_cvt(smem, rot, a.in[I_PWQ] + (size_t)l * 1024 * 1024, 1024, 1024, WSP(bf16_t, O_PWQT) + (size_t)l * 1024 * 1024, 1024, a.in[I_FFN] + l * 1024);
        for (int c = 0; c < 2; ++c)
            transpose_cvt(smem, rot, a.in[I_W1] + (size_t)(l * 2 + c) * 2048 * 128, 2048, 128, WSP(bf16_t, O_W1T) + (size_t)(l * 2 + c) * 128 * 2048, 2048);
        for (int g = 0; g < 4; ++g)
            transpose_cvt(smem, rot, a.in[I_POOLW] + (size_t)(l * 4 + g) * 4096, 64, 64, WSP(bf16_t, O_POOLT) + (size_t)(l * 4 + g) * 4096, 64);
    }
    const int gtid = blockIdx.x * 256 + threadIdx.x, gsz = gridDim.x * 256;
    {
        bf16_t* o = WSP(bf16_t, O_SGUW);
        const float* w = a.in[I_SGUW];
        for (int idx = gtid; idx < NL * 4 * 128 * 128; idx += gsz) {
            const int t = (idx >> 7) & 127, s = idx & 127;
            o[idx] = (bf16_t)f2bf(s <= t ? w[idx] : 0.f);
        }
    }
    {
        bf16_t* o = WSP(bf16_t, O_KEYS);
        for (int idx = gtid; idx < NL * 2 * 8192; idx += gsz) {
            const int l = idx >> 14, half = (idx >> 13) & 1, rem = idx & 8191;
            o[idx] = (bf16_t)f2bf((half ? a.in[I_K2] : a.in[I_K1])[l * 8192 + rem]);
        }
    }
    {
        float* o = WSP(float, O_PW1);
        for (int idx = gtid; idx < NL * 2 * 32 * 128; idx += gsz) {
            const int lc = idx >> 12, kp = (idx >> 7) & 31, e = idx & 127;
            const float* pe = a.in[I_PE] + (size_t)lc * 2048 + kp * 64;
            const float* w1 = a.in[I_W1] + ((size_t)lc * 2048 + kp * 64) * 128 + e;
            float s_ = 0.f;
#pragma unroll 8
            for (int k = 0; k < 64; ++k) s_ += pe[k] * w1[(size_t)k * 128];
            o[idx] = s_;
        }
    }
}

DEV void ph_peercvt(const Args& a, int l) {
    const int wave = threadIdx.x >> 6, lane = threadIdx.x & 63;
    for (int rw0 = (blockIdx.x * 4 + wave) * 4; rw0 < 2 * 16384; rw0 += gridDim.x * 16) {
        const int tb = rw0 >> 14, e0 = rw0 & 16383;
        const float4* src = (const float4*)((tb ? a.in[I_PV] : a.in[I_PU]) + ((size_t)l * 16384 + e0) * 1024);
        float4 v[4][4];
#pragma unroll
        for (int r = 0; r < 4; ++r)
#pragma unroll
            for (int i = 0; i < 4; ++i) v[r][i] = src[r * 256 + lane + 64 * i];
        if (tb == 0) {
#pragma unroll
            for (int i = 0; i < 4; ++i) {
                const float4 g4 = ((const float4*)(a.in[I_FFN] + l * 1024))[lane + 64 * i];
#pragma unroll
                for (int r = 0; r < 4; ++r) { v[r][i].x *= g4.x; v[r][i].y *= g4.y; v[r][i].z *= g4.z; v[r][i].w *= g4.w; }
            }
        }
#pragma unroll
        for (int r = 0; r < 4; ++r) {
            float mx = 0.f;
#pragma unroll
            for (int i = 0; i < 4; ++i)
                mx = fmaxf(mx, fmaxf(fmaxf(fabsf(v[r][i].x), fabsf(v[r][i].y)), fmaxf(fabsf(v[r][i].z), fabsf(v[r][i].w))));
            mx = wmaxf(mx);
            const float q = mx > 0.f ? 224.f / mx : 1.f;
            unsigned* dst = (unsigned*)(a.ws + (tb ? O_PVB : O_PU) + (size_t)(e0 + r) * 1024);
#pragma unroll
            for (int i = 0; i < 4; ++i) {
                int w = __builtin_amdgcn_cvt_pk_fp8_f32(v[r][i].x * q, v[r][i].y * q, 0, false);
                w = __builtin_amdgcn_cvt_pk_fp8_f32(v[r][i].z * q, v[r][i].w * q, w, true);
                dst[lane + 64 * i] = (unsigned)w;
            }
            if (lane == 0) WSP(float, O_PSC)[tb * 16384 + e0 + r] = mx > 0.f ? mx * (1.f / 224.f) : 1.f;
        }
    }
}

DEV void ph_mem1(const Args& a) {
    for (int l = 0; l < NL; ++l)
        rmsnorm_rows(a.in[I_MEM], a.in[I_MEMN] + l * 1024, WSP(bf16_t, O_MEMH) + (size_t)l * 512 * 1024, 512);
}
DEV void ph_mem2(const Args& a, unsigned char* smem, int block0) {
    const int G = gridDim.x;
    for (int it = ((int)blockIdx.x - block0 % G + G) % G; it < 64; it += G) {
        const int l = it >> 5, which = (it >> 4) & 1, mt = (it >> 2) & 3, nt = it & 3;
        const bf16_t* A = WSP(bf16_t, O_MEMH) + (size_t)l * 512 * 1024 + (size_t)mt * 128 * 1024;
        const bf16_t* Bt = WSP(bf16_t, which ? O_XWVT : O_XWKT) + (size_t)l * 512 * 1024 + (size_t)nt * 128 * 1024;
        float* o = WSP(float, O_XKVT) + (size_t)(l * 2 + which) * 512 * 512;
        f32x4 acc[4][4];
        acc_zero(acc);
        gemm_kloop<4, 4>(smem, 1024, [&](int r, int k0) { return A + (size_t)r * 1024 + k0; },
                                [&](int n, int k0) { return Bt + (size_t)n * 1024 + k0; }, acc);
        gemm_epi<4, 4>(acc, [&](int row, int col, float v) { o[(size_t)(mt * 128 + row) * 512 + nt * 128 + col] = v; });
    }
}
DEV void ph_mem3(const Args& a) {
    const int wave = threadIdx.x >> 6, lane = threadIdx.x & 63;
    for (int rw = blockIdx.x * 4 + wave; rw < NL * 512; rw += gridDim.x * 4) {
        const int l = rw >> 9, r = rw & 511, b = r >> 8, m = r & 255;
        const float* kr = WSP(float, O_XKVT) + ((size_t)(l * 2 + 0) * 512 + r) * 512 + lane * 8;
        const float* vr = WSP(float, O_XKVT) + ((size_t)(l * 2 + 1) * 512 + r) * 512 + lane * 8;
        const int h = lane >> 4, d0 = (lane & 15) * 8;
        const float* kn = a.in[I_XKN] + l * 128;
        float f[8], ss = 0.f;
#pragma unroll
        for (int i = 0; i < 8; ++i) { f[i] = kr[i]; ss += f[i] * f[i]; }
        ss = sum8(ss); ss += __shfl_xor(ss, 8);
        const float rs = rsqrtf(ss * (1.f / 128.f) + EPS);
        u32x4 o;
        o.x = pk2(f[0] * rs * kn[d0 + 0], f[1] * rs * kn[d0 + 1]);
        o.y = pk2(f[2] * rs * kn[d0 + 2], f[3] * rs * kn[d0 + 3]);
        o.z = pk2(f[4] * rs * kn[d0 + 4], f[5] * rs * kn[d0 + 5]);
        o.w = pk2(f[6] * rs * kn[d0 + 6], f[7] * rs * kn[d0 + 7]);
        *(u32x4*)(WSP(bf16_t, O_XK) + ((size_t)((l * 2 + b) * 4 + h) * 256 + m) * 128 + d0) = o;
        bf16_t* vt = WSP(bf16_t, O_XVT) + ((size_t)((l * 2 + b) * 4 + h) * 128 + d0) * 256 + m;
#pragma unroll
        for (int i = 0; i < 8; ++i) vt[(size_t)i * 256] = (bf16_t)f2bf(vr[i]);
    }
}

DEV void ph_gemm1(const Args& a, int l, unsigned char* smem) {
    const bf16_t* A = WSP(bf16_t, O_XN);
    const bf16_t* Bt = WSP(bf16_t, O_WINT) + (size_t)l * INW * 1024;
    bf16_t* z = WSP(bf16_t, O_ZBUF);
    const float* rsp = WSP(float, O_RSS);
    for (TileIter ti(256, 8); ti.valid(); ti.next()) {
        const int mt = ti.mt(), nt = ti.nt();
        const int m0 = mt * 128, n0 = nt * 256;
        if (nt < 7) {
            f32x4 acc[4][8];
            acc_zero(acc);
            gemm_kloop32<4, 8>(smem, 1024, [&](int r, int k0) { return A + (size_t)(m0 + r) * 1024 + k0; },
                               [&](int n, int k0) { return Bt + (size_t)(n0 + n) * 1024 + k0; }, acc);
            const int lane = threadIdx.x & 63, wave = threadIdx.x >> 6, wm = wave >> 1, wn = wave & 1, fr = lane & 15, fq = lane >> 4;
#pragma unroll
            for (int m = 0; m < 4; ++m)
#pragma unroll
                for (int j = 0; j < 4; ++j) {
                    const int row = m0 + wm * 64 + m * 16 + fq * 4 + j;
                    const float rs = row_rstd(rsp, row);
#pragma unroll
                    for (int n = 0; n < 8; ++n) z[(size_t)row * NZ + n0 + wn * 128 + n * 16 + fr] = (bf16_t)f2bf(acc[m][n][j] * rs);
                }
        } else {
            f32x4 acc[4][9];
            acc_zero(acc);
            gemm_kloop32<4, 9>(smem, 1024, [&](int r, int k0) { return A + (size_t)(m0 + r) * 1024 + k0; },
                               [&](int n, int k0) { return Bt + (size_t)(n0 + n) * 1024 + k0; }, acc);
            const int lane = threadIdx.x & 63, wave = threadIdx.x >> 6, wm = wave >> 1, wn = wave & 1, fr = lane & 15, fq = lane >> 4;
#pragma unroll
            for (int m = 0; m < 4; ++m)
#pragma unroll
                for (int j = 0; j < 4; ++j) {
                    const int row = m0 + wm * 64 + m * 16 + fq * 4 + j;
                    const float rs = row_rstd(rsp, row);
#pragma unroll
                    for (int n = 0; n < 9; ++n) {
                        const int col = n0 + wn * 144 + n * 16 + fr;
                        if (col < NZ) z[(size_t)row * NZ + col] = (bf16_t)f2bf(acc[m][n][j] * rs);
                    }
                }
        }
    }
}

DEV void ph_post(const Args& a, int l, unsigned char* smem) {
    const bf16_t* zb = WSP(bf16_t, O_ZBUF);
    bf16_t* vt = (bf16_t*)smem;
    const float* qnw = a.in[I_QN] + l * 64;
    const float* knw = a.in[I_KN] + l * 192;
    const float* lng = a.in[I_LNG] + l * 256;
    const float* lnb = a.in[I_LNB] + l * 256;
    const int tid = threadIdx.x, wave = tid >> 6, lane = tid & 63;
    for (int it = blockIdx.x; it < T / 64; it += gridDim.x) {
        const int t0 = it * 64, b = t0 / S, s0 = t0 - b * S;
        __syncthreads();
        float wsum_[8];
#pragma unroll
        for (int e = 0; e < 8; ++e) wsum_[e] = 0.f;
        u32x4 nq, nkv, nsg, npl;
        {
            const bf16_t* row0 = zb + (size_t)(t0 + wave * 16) * NZ;
            nq = *(const u32x4*)(row0 + 8 * lane);
            nkv = *(const u32x4*)(row0 + 768 + 8 * lane);
            nsg = *(const u32x4*)(row0 + ZSGU + 8 * lane);
            npl = *(const u32x4*)(row0 + ZPOOL + 8 * (lane & 31));
        }
        for (int i = 0; i < 16; ++i) {
            const int tl = wave * 16 + i, t = t0 + tl, s = s0 + tl;
            const bf16_t* row = zb + (size_t)t * NZ;
            const u32x4 cq = nq, ckv = nkv, csg = nsg, cpl = npl;
            if (i + 1 < 16) {
                nq = *(const u32x4*)(row + NZ + 8 * lane);
                nkv = *(const u32x4*)(row + NZ + 768 + 8 * lane);
                nsg = *(const u32x4*)(row + NZ + ZSGU + 8 * lane);
                npl = *(const u32x4*)(row + NZ + ZPOOL + 8 * (lane & 31));
            }
            {
                const u32x4 r = cq;
                float f[8]; unpack8(r, f);
                float ss = 0.f;
#pragma unroll
                for (int e = 0; e < 8; ++e) ss += f[e] * f[e];
                ss = sum8(ss);
                const float rs = rsqrtf(ss * (1.f / 64.f) + EPS) * (0.125f * LOG2E);
                const int d0 = (lane & 7) * 8;
                u32x4 o;
                o.x = pk2(f[0] * rs * qnw[d0 + 0], f[1] * rs * qnw[d0 + 1]);
                o.y = pk2(f[2] * rs * qnw[d0 + 2], f[3] * rs * qnw[d0 + 3]);
                o.z = pk2(f[4] * rs * qnw[d0 + 4], f[5] * rs * qnw[d0 + 5]);
                o.w = pk2(f[6] * rs * qnw[d0 + 6], f[7] * rs * qnw[d0 + 7]);
                *(u32x4*)(WSP(bf16_t, O_QN) + (size_t)t * 512 + 8 * lane) = o;
            }
            {
                const u32x4 r = ckv;
                const int c6 = 2 + (lane >> 4), g = (lane >> 3) & 1, d0 = (lane & 7) * 8;
                float f[8]; unpack8(r, f);
                float ss = 0.f;
#pragma unroll
                for (int e = 0; e < 8; ++e) ss += f[e] * f[e];
                ss = sum8(ss);
                if ((c6 & 1) == 0) {
                    const float* kn = knw + (c6 == 2 ? 64 : 128);
                    const float rs = rsqrtf(ss * (1.f / 64.f) + EPS);
                    u32x4 o;
                    o.x = pk2(f[0] * rs * kn[d0 + 0], f[1] * rs * kn[d0 + 1]);
                    o.y = pk2(f[2] * rs * kn[d0 + 2], f[3] * rs * kn[d0 + 3]);
                    o.z = pk2(f[4] * rs * kn[d0 + 4], f[5] * rs * kn[d0 + 5]);
                    o.w = pk2(f[6] * rs * kn[d0 + 6], f[7] * rs * kn[d0 + 7]);
                    bf16_t* dst = WSP(bf16_t, c6 == 2 ? O_KSLC : O_KWIN) + ((size_t)((b * 2 + g) * S + s)) * 64 + d0;
                    *(u32x4*)dst = o;
                } else {
                    const int which = (c6 - 3) >> 1;
                    bf16_t* dst = vt + ((which * 2 + g) * 64 + d0) * 72 + tl;
                    const unsigned w[4] = {r.x, r.y, r.z, r.w};
#pragma unroll
                    for (int e = 0; e < 4; ++e) {
                        dst[(2 * e) * 72] = (bf16_t)(w[e] & 0xffffu);
                        dst[(2 * e + 1) * 72] = (bf16_t)(w[e] >> 16);
                    }
                }
            }
            if (lane < 24) {
                const float z = bflo((unsigned)row[ZG + lane]);
                WSP(float, O_GATE)[(size_t)t * 24 + lane] = sigmoidf_(z);
            }
            {
                const u32x4 r = csg;
                float f[8]; unpack8(r, f);
                float sm = 0.f;
#pragma unroll
                for (int e = 0; e < 8; ++e) { f[e] = gelu_t(f[e]); sm += f[e]; }
                sm = sum16(sm);
                sm += __shfl_xor(sm, 16);
                const float mu = sm * (1.f / 256.f);
                float vr = 0.f;
#pragma unroll
                for (int e = 0; e < 8; ++e) vr += (f[e] - mu) * (f[e] - mu);
                vr = sum16(vr);
                vr += __shfl_xor(vr, 16);
                const float rs = rsqrtf(vr * (1.f / 256.f) + EPS);
                u32x4 o;
                if (lane < 32) {
                    o.x = pk2(f[0], f[1]); o.y = pk2(f[2], f[3]); o.z = pk2(f[4], f[5]); o.w = pk2(f[6], f[7]);
                    *(u32x4*)(WSP(bf16_t, O_UG) + (size_t)t * 256 + 8 * lane) = o;
                } else {
                    const int c0 = 8 * (lane - 32);
                    float y[8];
#pragma unroll
                    for (int e = 0; e < 8; ++e) y[e] = (f[e] - mu) * rs * lng[c0 + e] + lnb[c0 + e];
                    o.x = pk2(y[0], y[1]); o.y = pk2(y[2], y[3]); o.z = pk2(y[4], y[5]); o.w = pk2(y[6], y[7]);
                    *(u32x4*)(WSP(bf16_t, O_VLN) + (size_t)t * 256 + c0) = o;
                }
            }
            if (lane < 32) {
                const int gi = lane >> 3, w = 2 << gi, c0 = 8 * lane;
                float p[8];
                unpack8(cpl, p);
                if (i == 0) {
#pragma unroll
                    for (int e = 0; e < 8; ++e) wsum_[e] = 0.f;
                    for (int k = 1; k < 16; ++k) {
                        if (k < w && s - k >= 0) {
                            const u32x4 r = *(const u32x4*)(row - (size_t)k * NZ + ZPOOL + c0);
                            float f[8]; unpack8(r, f);
#pragma unroll
                            for (int e = 0; e < 8; ++e) wsum_[e] += f[e];
                        }
                    }
                } else if (s - w >= 0) {
                    const u32x4 r = *(const u32x4*)(row - (size_t)w * NZ + ZPOOL + c0);
                    float f[8]; unpack8(r, f);
#pragma unroll
                    for (int e = 0; e < 8; ++e) wsum_[e] -= f[e];
                }
#pragma unroll
                for (int e = 0; e < 8; ++e) wsum_[e] += p[e];
                const float ic = 1.f / (float)min(s + 1, w);
                u32x4 o;
                o.x = pk2(wsum_[0] * ic - p[0], wsum_[1] * ic - p[1]);
                o.y = pk2(wsum_[2] * ic - p[2], wsum_[3] * ic - p[3]);
                o.z = pk2(wsum_[4] * ic - p[4], wsum_[5] * ic - p[5]);
                o.w = pk2(wsum_[6] * ic - p[6], wsum_[7] * ic - p[7]);
                *(u32x4*)(WSP(bf16_t, O_DPOOL) + (size_t)t * 256 + c0) = o;
            }
        }
        __syncthreads();
        {
            const int which = tid >> 7, g = (tid >> 6) & 1, d = tid & 63;
            const bf16_t* src = vt + tid * 72;
            bf16_t* dst = WSP(bf16_t, which ? O_VWINT : O_VSLCT) + ((size_t)((b * 2 + g) * 64 + d)) * S + s0;
#pragma unroll
            for (int j = 0; j < 8; ++j) *(u32x4*)(dst + 8 * j) = *(const u32x4*)(src + 8 * j);
        }
    }
}

DEV void ph_cmp1(const Args& a, int l, unsigned char* smem) {
    const bf16_t* zb = WSP(bf16_t, O_ZBUF);
    const bf16_t* W1T = WSP(bf16_t, O_W1T) + (size_t)(l * 2) * 128 * 2048;
    const float* pw1p = WSP(float, O_PW1) + (size_t)l * 2 * 32 * 128;
    bf16_t* hid = WSP(bf16_t, O_HID);
    for (int it = blockIdx.x; it < 256; it += gridDim.x) {
        const int c = it >> 7, mt = (it >> 1) & 63, nt = it & 1, m0 = mt * 64, n0 = nt * 64;
        f32x4 acc[2][2];
        acc_zero(acc);
        gemm_kloop<2, 2>(smem, 2048,
            [&](int r, int k0) {
                const int m = m0 + r, bg = m >> 10, n = min(m & 1023, 1022), b = bg >> 1, g = bg & 1;
                return zb + ((size_t)(b * S + 16 * n + (k0 >> 6))) * NZ + ZKV + c * 128 + g * 64;
            },
            [&](int n, int k0) { return W1T + ((size_t)(c * 128 + n0 + n)) * 2048 + k0; }, acc);
        float bias[2];
        {
            const int lane = threadIdx.x & 63, wn = (threadIdx.x >> 6) & 1, fr = lane & 15;
#pragma unroll
            for (int n = 0; n < 2; ++n) {
                float b_ = 0.f;
                for (int kp = 0; kp < 32; ++kp) b_ += pw1p[((size_t)c * 32 + kp) * 128 + n0 + wn * 32 + n * 16 + fr];
                bias[n] = b_;
            }
        }
        {
            const int lane = threadIdx.x & 63, wave = threadIdx.x >> 6, wm = wave >> 1, wn = wave & 1, fr = lane & 15, fq = lane >> 4;
#pragma unroll
            for (int m = 0; m < 2; ++m)
#pragma unroll
                for (int n = 0; n < 2; ++n)
#pragma unroll
                    for (int j = 0; j < 4; ++j)
                        hid[((size_t)(c * 4096 + m0 + wm * 32 + m * 16 + fq * 4 + j)) * 128 + n0 + wn * 32 + n * 16 + fr] =
                            (bf16_t)f2bf(gelu_t(acc[m][n][j] + bias[n]));
        }
    }
}
DEV void ph_cmp2(const Args& a, int l) {
    const float* w2 = a.in[I_W2] + (size_t)l * 2 * 128 * 64;
    const float* kn0 = a.in[I_KN] + l * 192;
    const bf16_t* hid = WSP(bf16_t, O_HID);
    const int wave = threadIdx.x >> 6, lane = threadIdx.x & 63;
    for (int rw = blockIdx.x * 4 + wave; rw < 8192; rw += gridDim.x * 4) {
        const int c = rw >> 12, m = rw & 4095, bg = m >> 10, n = m & 1023;
        const bf16_t* h = hid + ((size_t)(c * 4096 + m)) * 128;
        float acc = 0.f;
        for (int e = 0; e < 128; ++e) acc += bflo((unsigned)h[e]) * w2[(c * 128 + e) * 64 + lane];
        if (c == 0) {
            const float ss = wsum(acc * acc);
            const float v = acc * rsqrtf(ss * (1.f / 64.f) + EPS) * kn0[lane];
            WSP(bf16_t, O_KC)[((size_t)(bg * 1024 + n)) * 64 + lane] = (n < 1023) ? (bf16_t)f2bf(v) : (bf16_t)0;
        } else {
            WSP(bf16_t, O_VCT)[((size_t)(bg * 64 + lane)) * 1024 + n] = (n < 1023) ? (bf16_t)f2bf(acc) : (bf16_t)0;
        }
    }
}

DEV bf16x8 packp(const float* pa, const float* pb) {
    u32x4 w;
    w.x = pk2(pa[0], pa[1]); w.y = pk2(pa[2], pa[3]); w.z = pk2(pb[0], pb[1]); w.w = pk2(pb[2], pb[3]);
    return __builtin_bit_cast(bf16x8, w);
}
constexpr float NEGBIG = -1.0e30f;
DEV bf16x8 ones_frag() { const short o = (short)0x3F80; return (bf16x8){o, o, o, o, o, o, o, o}; }
struct KFrag { bf16x8 ka[2], kb[2]; };
DEV void k_load(KFrag& f, const bf16_t* __restrict__ kb, int kb0, int q4, int ia) {
#pragma unroll
    for (int ks = 0; ks < 2; ++ks) {
        f.ka[ks] = ld8(kb + (size_t)(kb0 + ia) * 64 + ks * 32 + q4 * 8);
        f.kb[ks] = ld8(kb + (size_t)(kb0 + ia + 4) * 64 + ks * 32 + q4 * 8);
    }
}
template <class MaskF, class FullF>
DEV void attn_group(const KFrag& f, const bf16_t* __restrict__ vt, size_t vstride, int G, const bf16x8 (&qf)[4][2], float M0, MaskF valid, FullF full,
                    f32x4 (&o)[4][4], f32x4 (&lacc)[4], int col, int q4) {
    const bf16x8 ones = ones_frag();
    const int kb0 = 32 * G;
    bf16x8 va[4];
#pragma unroll
    for (int dt = 0; dt < 4; ++dt) va[dt] = ld8(vt + (size_t)(dt * 16 + col) * vstride + kb0 + q4 * 8);
    const bool fullg = full(G);
#pragma unroll
    for (int ct = 0; ct < 4; ++ct) {
        f32x4 sa = {-M0, -M0, -M0, -M0}, sb = {-M0, -M0, -M0, -M0};
        if (!fullg) {
#pragma unroll
            for (int e = 0; e < 4; ++e) {
                const int key = kb0 + 8 * q4 + e;
                sa[e] = valid(ct, key) ? -M0 : NEGBIG;
                sb[e] = valid(ct, key + 4) ? -M0 : NEGBIG;
            }
        }
#pragma unroll
        for (int ks = 0; ks < 2; ++ks) { sa = mfma16(f.ka[ks], qf[ct][ks], sa); sb = mfma16(f.kb[ks], qf[ct][ks], sb); }
        float pa[4], pb[4];
#pragma unroll
        for (int e = 0; e < 4; ++e) { pa[e] = fexp2(sa[e]); pb[e] = fexp2(sb[e]); }
        const bf16x8 pf = packp(pa, pb);
#pragma unroll
        for (int dt = 0; dt < 4; ++dt) o[ct][dt] = mfma16(va[dt], pf, o[ct][dt]);
        lacc[ct] = mfma16(ones, pf, lacc[ct]);
    }
}
template <class MaskF, class FullF>
DEV void attn_shared(const bf16_t* __restrict__ kb, const bf16_t* __restrict__ vt, size_t vstride, int G0, int G1, const bf16x8 (&qf)[4][2],
                     float M0, MaskF valid, FullF full, f32x4 (&o)[4][4], f32x4 (&lacc)[4], int col, int q4, int ia) {
    if (G0 > G1) return;
    KFrag fa, fb;
    k_load(fa, kb, 32 * G0, q4, ia);
    for (int G = G0; G <= G1; G += 2) {
        if (G + 1 <= G1) k_load(fb, kb, 32 * (G + 1), q4, ia);
        attn_group(fa, vt, vstride, G, qf, M0, valid, full, o, lacc, col, q4);
        if (G + 1 <= G1) {
            if (G + 2 <= G1) k_load(fa, kb, 32 * (G + 2), q4, ia);
            attn_group(fb, vt, vstride, G + 1, qf, M0, valid, full, o, lacc, col, q4);
        }
    }
}

template <class MaskF, class FullF>
DEV void attn_ring(unsigned char* smem, int tid_, const bf16_t* __restrict__ ksrc, const bf16_t* __restrict__ vsrc, size_t vstride, int jlo, int jhi,
                   const bf16x8 (&qf)[4][2], float M0, MaskF valid, FullF full, f32x4 (&o)[4][4], f32x4 (&lacc)[4], int col, int q4, int ia) {
    if (jlo <= jhi) {
        const bf16x8 ones = ones_frag();
        int sR[2], sC[2];
#pragma unroll
        for (int i = 0; i < 2; ++i) stage_rc(tid_ * 16 + i * 4096, sR[i], sC[i]);
        auto stage = [&](int j, int buf) {
            unsigned char* Kb = smem + buf * 16384;
#pragma unroll
            for (int i = 0; i < 2; ++i) {
                glds16(ksrc + (size_t)(64 * j + sR[i]) * 64 + sC[i], Kb + tid_ * 16 + i * 4096);
                glds16(vsrc + (size_t)sR[i] * vstride + 64 * j + sC[i], Kb + 8192 + tid_ * 16 + i * 4096);
            }
        };
        const int ka_off = ((ia >> 4) * 2048) + (((ia & 15) * 64 + q4 * 16) ^ ((((ia & 15) >> 3) & 1) << 5));
        const int kb_off = (((ia + 4) >> 4) * 2048) + ((((ia + 4) & 15) * 64 + q4 * 16) ^ (((((ia + 4) & 15) >> 3) & 1) << 5));
        const int v_off = (col * 64 + q4 * 16) ^ (((col >> 3) & 1) << 5);
#pragma unroll
        for (int ct = 0; ct < 4; ++ct)
#pragma unroll
            for (int ks = 0; ks < 2; ++ks) asm volatile("" ::"v"(qf[ct][ks]));
        asm volatile("s_waitcnt vmcnt(0)" ::: "memory");
        stage(jlo, 0);
        if (jlo + 1 <= jhi) stage(jlo + 1, 1);
        int slot = 0;
        for (int j = jlo; j <= jhi; ++j) {
            if (j + 1 <= jhi) asm volatile("s_waitcnt vmcnt(4)" ::: "memory");
            else asm volatile("s_waitcnt vmcnt(0)" ::: "memory");
            __builtin_amdgcn_s_barrier();
            if (j + 2 <= jhi) stage(j + 2, slot >= 1 ? slot - 1 : 2);
            const unsigned char* Kb = smem + slot * 16384;
#pragma unroll
            for (int G2 = 0; G2 < 2; ++G2) {
                bf16x8 ka[2], kbf[2], va[4];
#pragma unroll
                for (int ks = 0; ks < 2; ++ks) {
                    ka[ks] = *(const bf16x8*)(Kb + G2 * 4096 + ks * 1024 + ka_off);
                    kbf[ks] = *(const bf16x8*)(Kb + G2 * 4096 + ks * 1024 + kb_off);
                }
#pragma unroll
                for (int dt = 0; dt < 4; ++dt) va[dt] = *(const bf16x8*)(Kb + 8192 + dt * 2048 + G2 * 1024 + v_off);
                const int kb0 = 64 * j + 32 * G2;
                const bool fullg = full(kb0);
#pragma unroll
                for (int ct = 0; ct < 4; ++ct) {
                    f32x4 sa = {-M0, -M0, -M0, -M0}, sb = {-M0, -M0, -M0, -M0};
                    if (!fullg) {
#pragma unroll
                        for (int e = 0; e < 4; ++e) {
                            const int key = kb0 + 8 * q4 + e;
                            sa[e] = valid(ct, key) ? -M0 : NEGBIG;
                            sb[e] = valid(ct, key + 4) ? -M0 : NEGBIG;
                        }
                    }
#pragma unroll
                    for (int ks = 0; ks < 2; ++ks) { sa = mfma16(ka[ks], qf[ct][ks], sa); sb = mfma16(kbf[ks], qf[ct][ks], sb); }
                    float pa[4], pb[4];
#pragma unroll
                    for (int e = 0; e < 4; ++e) { pa[e] = fexp2(sa[e]); pb[e] = fexp2(sb[e]); }
                    const bf16x8 pf = packp(pa, pb);
#pragma unroll
                    for (int dt = 0; dt < 4; ++dt) o[ct][dt] = mfma16(va[dt], pf, o[ct][dt]);
                    lacc[ct] = mfma16(ones, pf, lacc[ct]);
                }
            }
            slot = (slot == 2) ? 0 : slot + 1;
        }
    }
    __syncthreads();
}

DEV void ph_nsa(const Args& a, int l, unsigned char* smem) {
    const int tid = threadIdx.x, wave = tid >> 6, lane = tid & 63;
#define LANE_VARS int ln_ = lane; asm volatile("" : "+v"(ln_)); const int col = ln_ & 15, q4 = ln_ >> 4, qq = col >> 2, r = col & 3, ia = 8 * (col >> 2) + (col & 3), h = g * 4 + r; (void)ia; (void)h; (void)qq; (void)r; (void)q4;
    const bf16_t* qn = WSP(bf16_t, O_QN);
    const float* gate = WSP(float, O_GATE);
    bf16_t* oa = WSP(bf16_t, O_OA);
    float M0;
    {
        const float* kn = a.in[I_KN] + l * 192;
        const float gq = wmaxf(fabsf(a.in[I_QN][l * 64 + lane]));
        const float gk = wmaxf(fmaxf(fabsf(kn[lane]), fmaxf(fabsf(kn[64 + lane]), fabsf(kn[128 + lane]))));
        M0 = 8.f * gq * gk * LOG2E * 1.01f;
    }
    float* imp = (float*)smem + wave * 2080;
    unsigned* selbits = (unsigned*)(smem + 49152);
    const bool xmap = (gridDim.x % 8) == 0;
    const int it0 = xmap ? ((blockIdx.x & 1) + 2 * (blockIdx.x >> 3)) : blockIdx.x;
    const int itn = xmap ? 256 : 1024;
    const int its = xmap ? (gridDim.x >> 2) : gridDim.x;
    for (int it = it0; it < itn; it += its) {
        const int bg = xmap ? ((blockIdx.x & 7) >> 1) : (it & 3);
        int tt = xmap ? it : (it >> 2);
        tt = (tt < 128) ? tt : (383 - tt);
        const int b = bg >> 1, g = bg & 1, cur = tt;
        const int tw0 = tt * 64 + wave * 16;
#define LOAD_QF(qf) bf16x8 qf[4][2]; _Pragma("unroll") for (int ct = 0; ct < 4; ++ct) _Pragma("unroll") for (int ks = 0; ks < 2; ++ks) \
            qf[ct][ks] = ld8(qn + ((size_t)b * S + tw0 + 4 * ct + qq) * 512 + h * 64 + ks * 32 + q4 * 8);
        const bf16_t* kcb = WSP(bf16_t, O_KC) + (size_t)bg * 1024 * 64;
        const bf16_t* vcb = WSP(bf16_t, O_VCT) + (size_t)bg * 64 * 1024;
        float linv_c[4];
        const int tmax = tw0 + 15;
        const int nvis = tmax >= 31 ? ((tmax - 31) >> 4) + 1 : 0;
        const int ng = (nvis + 31) >> 5;
        for (int rp1 = 0; rp1 < ((REP_ID == 20 && l == 0) ? 2 : 1); ++rp1) {
            LANE_VARS
            LOAD_QF(qf)
            f32x4 o[4][4], lacc[4];
#pragma unroll
            for (int ct = 0; ct < 4; ++ct) {
                lacc[ct] = (f32x4){0.f, 0.f, 0.f, 0.f};
#pragma unroll
                for (int dt = 0; dt < 4; ++dt) o[ct][dt] = (f32x4){0.f, 0.f, 0.f, 0.f};
            }
            {
                const int tmax_tile = tt * 64 + 63;
                const int nvis_tile = tmax_tile >= 31 ? ((tmax_tile - 31) >> 4) + 1 : 0;
                int tid_ = tid;
                asm volatile("" : "+v"(tid_));
                attn_ring(smem, tid_, kcb, vcb, 1024, 0, ((nvis_tile + 63) >> 6) - 1, qf, M0,
                          [&](int ct, int n) { return 16 * n + 31 <= tw0 + 4 * ct + qq; },
                          [&](int n0) { return 16 * n0 + 527 <= tw0; }, o, lacc, col, q4, ia);
            }
#pragma unroll
            for (int ct = 0; ct < 4; ++ct) {
                const float s_ = lacc[ct][0];
                linv_c[ct] = s_ > 0.f ? 1.f / s_ : 0.f;
                const size_t tok = (size_t)b * S + tw0 + 4 * ct + qq;
                const float sc = gate[tok * 24 + h * 3 + 0] * linv_c[ct];
#pragma unroll
                for (int dt = 0; dt < 4; ++dt) {
                    u32x2 w;
                    w.x = pk2(o[ct][dt][0] * sc, o[ct][dt][1] * sc);
                    w.y = pk2(o[ct][dt][2] * sc, o[ct][dt][3] * sc);
                    *(u32x2*)(oa + tok * 1024 + h * 64 + dt * 16 + 4 * q4) = w;
                }
            }
        }
        for (int i = lane; i < 128; i += 64) selbits[wave * 128 + i] = 0u;
        for (int rp2 = 0; rp2 < ((REP_ID == 21 && l == 0) ? 2 : 1); ++rp2)
#pragma unroll 1
        for (int cp = 0; cp < 2; ++cp) {
            LANE_VARS
            const int tq7 = tw0 + 8 * cp + 7;
            const int nv = tq7 >= 31 ? ((tq7 - 31) >> 4) + 1 : 0;
            const int ngc = (nv + 31) >> 5;
            bf16x8 qc[2][2];
#pragma unroll
            for (int c2 = 0; c2 < 2; ++c2)
#pragma unroll
                for (int ks = 0; ks < 2; ++ks) qc[c2][ks] = ld8(qn + ((size_t)b * S + tw0 + 8 * cp + 4 * c2 + qq) * 512 + h * 64 + ks * 32 + q4 * 8);
            for (int i = lane; i < 2080; i += 64) imp[i] = 0.f;
            lds_fence();
            if (cur >= 16) {
                for (int G = 0; G < ngc; ++G) {
                    const int kb0 = 32 * G;
                    bf16x8 ka[2], kb[2];
#pragma unroll
                    for (int ks = 0; ks < 2; ++ks) {
                        ka[ks] = ld8(kcb + (size_t)(kb0 + ia) * 64 + ks * 32 + q4 * 8);
                        kb[ks] = ld8(kcb + (size_t)(kb0 + ia + 4) * 64 + ks * 32 + q4 * 8);
                    }
#pragma unroll
                    for (int c2 = 0; c2 < 2; ++c2) {
                        const int t = tw0 + 8 * cp + 4 * c2 + qq;
                        const float li = (cp == 0) ? (c2 == 0 ? linv_c[0] : linv_c[1]) : (c2 == 0 ? linv_c[2] : linv_c[3]);
                        f32x4 sa, sb;
#pragma unroll
                        for (int e = 0; e < 4; ++e) {
                            const int n = kb0 + 8 * q4 + e;
                            sa[e] = (16 * n + 31 <= t) ? -M0 : NEGBIG;
                            sb[e] = (16 * (n + 4) + 31 <= t) ? -M0 : NEGBIG;
                        }
#pragma unroll
                        for (int ks = 0; ks < 2; ++ks) { sa = mfma16(ka[ks], qc[c2][ks], sa); sb = mfma16(kb[ks], qc[c2][ks], sb); }
                        float p[8];
#pragma unroll
                        for (int e = 0; e < 4; ++e) { p[e] = fexp2(sa[e]) * li; p[e + 4] = fexp2(sb[e]) * li; }
                        const float a0 = sum4(2.f * (p[0] + p[1] + p[2]) + p[3]);
                        const float a1 = sum4(p[3] + 2.f * (p[4] + p[5] + p[6]) + p[7]);
                        const float a2 = sum4(p[7]);
                        if (r == 0) {
                            const int j0 = 8 * G + 2 * q4;
                            float* ip = imp + (4 * c2 + qq) * 260 + j0;
                            atomicAdd(ip, a0);
                            atomicAdd(ip + 1, a1);
                            if (j0 + 2 < 256) atomicAdd(ip + 2, a2);
                        }
                    }
                }
            }
            lds_fence();
#pragma unroll 1
            for (int sub = 0; sub < 2; ++sub) {
                int ln2 = ln_;
                asm volatile("" : "+v"(ln2));
                const int qs = (ln2 >> 4) + 4 * sub, s16 = ln2 & 15;
                int mysel;
                if (cur < 16) {
                    mysel = (s16 <= cur) ? s16 : 0;
                } else {
                    unsigned e[16];
#pragma unroll
                    for (int i = 0; i < 16; ++i) {
                        const int j = s16 + 16 * i;
                        const bool valid = (j >= 1) && (j <= cur - 2);
                        e[i] = valid ? ((__float_as_uint(imp[qs * 260 + j]) & ~255u) | (unsigned)(255 - j)) : 0u;
                    }
                    mysel = (s16 == 0) ? 0 : ((s16 == 1) ? cur : cur - 1);
                    for (int itk = 0; itk < 13; ++itk) {
                        unsigned m = e[0];
#pragma unroll
                        for (int i = 1; i < 16; ++i) m = max(m, e[i]);
                        m = max16u(m);
#pragma unroll
                        for (int i = 0; i < 16; ++i) e[i] = (e[i] == m) ? 0u : e[i];
                        if (s16 == 3 + itk) mysel = 255 - (int)(m & 255u);
                    }
                }
                atomicOr(&selbits[(wave * 16 + 8 * cp + qs) * 8 + (mysel >> 5)], 1u << (mysel & 31));
            }
            lds_fence();
        }
        __syncthreads();
        for (int rp3 = 0; rp3 < ((REP_ID == 22 && l == 0) ? 2 : 1); ++rp3) {
            const bool last3 = (rp3 == ((REP_ID == 22 && l == 0) ? 1 : 0));
            const bf16_t* ksb = WSP(bf16_t, O_KSLC) + (size_t)bg * S * 64;
            const bf16_t* vsb = WSP(bf16_t, O_VSLCT) + (size_t)bg * 64 * S;
            LANE_VARS
            LOAD_QF(qf)
            f32x4 o[4][4], lacc[4];
#pragma unroll
            for (int ct = 0; ct < 4; ++ct) {
                lacc[ct] = (f32x4){0.f, 0.f, 0.f, 0.f};
#pragma unroll
                for (int dt = 0; dt < 4; ++dt) o[ct][dt] = (f32x4){0.f, 0.f, 0.f, 0.f};
            }
            const bf16x8 ones = ones_frag();
            int tid_ = tid;
            asm volatile("" : "+v"(tid_));
            int sR[2], sC[2];
#pragma unroll
            for (int i = 0; i < 2; ++i) stage_rc(tid_ * 16 + i * 4096, sR[i], sC[i]);
            auto stage = [&](int j, int buf) {
                unsigned char* Kb = smem + buf * 16384;
#pragma unroll
                for (int i = 0; i < 2; ++i) {
                    glds16(ksb + (size_t)(64 * j + sR[i]) * 64 + sC[i], Kb + tid_ * 16 + i * 4096);
                    glds16(vsb + (size_t)sR[i] * S + 64 * j + sC[i], Kb + 8192 + tid_ * 16 + i * 4096);
                }
            };
            const int ka_off = ((ia >> 4) * 2048) + (((ia & 15) * 64 + q4 * 16) ^ ((((ia & 15) >> 3) & 1) << 5));
            const int kb_off = (((ia + 4) >> 4) * 2048) + ((((ia + 4) & 15) * 64 + q4 * 16) ^ (((((ia + 4) & 15) >> 3) & 1) << 5));
            const int v_off = (col * 64 + q4 * 16) ^ (((col >> 3) & 1) << 5);
#pragma unroll
            for (int ct = 0; ct < 4; ++ct)
#pragma unroll
                for (int ks = 0; ks < 2; ++ks) asm volatile("" ::"v"(qf[ct][ks]));
            asm volatile("s_waitcnt vmcnt(0)" ::: "memory");
            stage(0, 0);
            if (cur >= 1) stage(1, 1);
            for (int j = 0; j <= cur; ++j) {
                if (j + 1 <= cur) asm volatile("s_waitcnt vmcnt(4)" ::: "memory");
                else asm volatile("s_waitcnt vmcnt(0)" ::: "memory");
                __builtin_amdgcn_s_barrier();
                if (j + 2 <= cur) stage(j + 2, (j + 2) % 3);
                const unsigned char* Kb = smem + (j % 3) * 16384;
                bool sbit[4];
                bool anyw = false;
#pragma unroll
                for (int ct = 0; ct < 4; ++ct) {
                    sbit[ct] = (selbits[(wave * 16 + 4 * ct + qq) * 8 + (j >> 5)] >> (j & 31)) & 1u;
                    anyw = anyw || sbit[ct];
                }
                if (__ballot(anyw) != 0ull) {
#pragma unroll
                    for (int G2 = 0; G2 < 2; ++G2) {
                        bf16x8 ka[2], kbf[2], va[4];
#pragma unroll
                        for (int ks = 0; ks < 2; ++ks) {
                            ka[ks] = *(const bf16x8*)(Kb + G2 * 4096 + ks * 1024 + ka_off);
                            kbf[ks] = *(const bf16x8*)(Kb + G2 * 4096 + ks * 1024 + kb_off);
                        }
#pragma unroll
                        for (int dt = 0; dt < 4; ++dt) va[dt] = *(const bf16x8*)(Kb + 8192 + dt * 2048 + G2 * 1024 + v_off);
#pragma unroll
                        for (int ct = 0; ct < 4; ++ct) {
                            if (__ballot(sbit[ct]) != 0ull) {
                                const float bias = sbit[ct] ? -M0 : NEGBIG;
                                f32x4 sa = {bias, bias, bias, bias}, sb = {bias, bias, bias, bias};
                                if (j == cur) {
                                    const int t = tw0 + 4 * ct + qq;
#pragma unroll
                                    for (int e = 0; e < 4; ++e) {
                                        const int key = 64 * j + 32 * G2 + 8 * q4 + e;
                                        sa[e] = (key <= t) ? bias : NEGBIG;
                                        sb[e] = (key + 4 <= t) ? bias : NEGBIG;
                                    }
                                }
#pragma unroll
                                for (int ks = 0; ks < 2; ++ks) { sa = mfma16(ka[ks], qf[ct][ks], sa); sb = mfma16(kbf[ks], qf[ct][ks], sb); }
                                float pa[4], pb[4];
#pragma unroll
                                for (int e = 0; e < 4; ++e) { pa[e] = fexp2(sa[e]); pb[e] = fexp2(sb[e]); }
                                const bf16x8 pf = packp(pa, pb);
#pragma unroll
                                for (int dt = 0; dt < 4; ++dt) o[ct][dt] = mfma16(va[dt], pf, o[ct][dt]);
                                lacc[ct] = mfma16(ones, pf, lacc[ct]);
                            }
                        }
                    }
                }
            }
#pragma unroll
            for (int ct = 0; ct < 4; ++ct) {
                const float s_ = lacc[ct][0];
                const size_t tok = (size_t)b * S + tw0 + 4 * ct + qq;
                const float sc = last3 ? gate[tok * 24 + h * 3 + 1] / s_ : 0.f;
#pragma unroll
                for (int dt = 0; dt < 4; ++dt) {
                    bf16_t* op = oa + tok * 1024 + h * 64 + dt * 16 + 4 * q4;
                    const u32x2 old = *(const u32x2*)op;
                    u32x2 w;
                    w.x = pk2(bflo(old.x) + o[ct][dt][0] * sc, bfhi(old.x) + o[ct][dt][1] * sc);
                    w.y = pk2(bflo(old.y) + o[ct][dt][2] * sc, bfhi(old.y) + o[ct][dt][3] * sc);
                    *(u32x2*)op = w;
                }
            }
            __syncthreads();
        }
        for (int rp4 = 0; rp4 < ((REP_ID == 23 && l == 0) ? 2 : 1); ++rp4) {
            const bool last4 = (rp4 == ((REP_ID == 23 && l == 0) ? 1 : 0));
            const bf16_t* kwb = WSP(bf16_t, O_KWIN) + (size_t)bg * S * 64;
            const bf16_t* vwb = WSP(bf16_t, O_VWINT) + (size_t)bg * 64 * S;
            LANE_VARS
            LOAD_QF(qf)
            f32x4 o[4][4], lacc[4];
#pragma unroll
            for (int ct = 0; ct < 4; ++ct) {
                lacc[ct] = (f32x4){0.f, 0.f, 0.f, 0.f};
#pragma unroll
                for (int dt = 0; dt < 4; ++dt) o[ct][dt] = (f32x4){0.f, 0.f, 0.f, 0.f};
            }
            {
                int tid_ = tid;
                asm volatile("" : "+v"(tid_));
                attn_ring(smem, tid_, kwb, vwb, (size_t)S, max(0, tt * 64 - 511) >> 6, tt, qf, M0,
                          [&](int ct, int key) { const int t = tw0 + 4 * ct + qq; return key <= t && t - key < 512; },
                          [&](int k0) { return k0 + 31 <= tw0 && tw0 + 15 - k0 < 512; }, o, lacc, col, q4, ia);
            }
#pragma unroll
            for (int ct = 0; ct < 4; ++ct) {
                const float s_ = lacc[ct][0];
                const size_t tok = (size_t)b * S + tw0 + 4 * ct + qq;
                const float sc = last4 ? gate[tok * 24 + h * 3 + 2] / s_ : 0.f;
#pragma unroll
                for (int dt = 0; dt < 4; ++dt) {
                    bf16_t* op = oa + tok * 1024 + h * 64 + dt * 16 + 4 * q4;
                    const u32x2 old = *(const u32x2*)op;
                    u32x2 w;
                    w.x = pk2(bflo(old.x) + o[ct][dt][0] * sc, bfhi(old.x) + o[ct][dt][1] * sc);
                    w.y = pk2(bflo(old.y) + o[ct][dt][2] * sc, bfhi(old.y) + o[ct][dt][3] * sc);
                    *(u32x2*)op = w;
                }
            }
        }
        __syncthreads();
    }
}

DEV void ph_sgu(const Args& a, int l, unsigned char* smem) {
    const bf16_t* W = WSP(bf16_t, O_SGUW) + (size_t)l * 4 * 128 * 128;
    const bf16_t* vln = WSP(bf16_t, O_VLN);
    const bf16_t* ug = WSP(bf16_t, O_UG);
    const float* sb = a.in[I_SGUB] + l * 512;
    bf16_t* ob = WSP(bf16_t, O_OA);
    for (int it = blockIdx.x; it < 1024; it += gridDim.x) {
        const int ch = it >> 2, g = it & 3, tc0 = ch * 128;
        f32x16 acc[2][1];
        acc_zero_rs(acc);
        gemm_kloop_rs<2, 1, true>(smem, 128, [&](int r, int k0) { return W + (size_t)(g * 128 + r) * 128 + k0; },
                               [&](int kl, int k0) { return vln + (size_t)(tc0 + k0 + kl) * 256 + g * 64; }, acc);
        gemm_epi_rs<2, 1>(acc, [&](int row, int col, float v) {
            const size_t idx = (size_t)(tc0 + row) * 256 + g * 64 + col;
            ob[(size_t)(tc0 + row) * 1024 + 512 + g * 64 + col] = (bf16_t)f2bf(bflo((unsigned)ug[idx]) * (v + sb[g * 128 + row]));
        });
    }
}
DEV void ph_pool(const Args& a, int l, unsigned char* smem) {
    const bf16_t* dp = WSP(bf16_t, O_DPOOL);
    const bf16_t* PT = WSP(bf16_t, O_POOLT) + (size_t)l * 4 * 4096;
    const float* sc = a.in[I_POOLS] + l * 256;
    bf16_t* oc = WSP(bf16_t, O_OA);
    for (int it = blockIdx.x; it < 1024; it += gridDim.x) {
        const int mt = it >> 2, g = it & 3, m0 = mt * 128;
        f32x4 acc[4][2];
        acc_zero(acc);
        gemm_kloop<4, 2>(smem, 64, [&](int r, int k0) { return dp + (size_t)(m0 + r) * 256 + g * 64 + k0; },
                                [&](int n, int k0) { return PT + (size_t)(g * 64 + n) * 64 + k0; }, acc);
        gemm_epi<4, 2>(acc, [&](int row, int col, float v) {
            oc[(size_t)(m0 + row) * 1024 + 768 + g * 64 + col] = (bf16_t)f2bf(v * sc[g * 64 + col]);
        });
    }
}
DEV void ph_merge(const Args& a, int l, unsigned char* smem) {
    const bf16_t* xn = WSP(bf16_t, O_XN);
    const bf16_t* WgT = WSP(bf16_t, O_WINT) + (size_t)l * INW * 1024 + (size_t)NZ * 1024;
    bf16_t* mg = WSP(bf16_t, O_MERGED);
    for (TileIter ti(256, 16); ti.valid(); ti.next()) {
        const int mt = ti.mt(), nt = ti.nt(), m0 = mt * 128, n0 = nt * 64;
        f32x4 accg[4][6];
        acc_zero(accg);
        gemm_kloop32<4, 6>(smem, 1024, [&](int r, int k0) { return xn + (size_t)(m0 + r) * 1024 + k0; },
                           [&](int R, int k0) {
                               const int wnr = R / 96, rem = R - wnr * 96, n = rem >> 4, fr_ = rem & 15;
                               return WgT + (size_t)((n >> 1) * 1024 + n0 + wnr * 32 + (n & 1) * 16 + fr_) * 1024 + k0;
                           }, accg);
        unsigned gpk[4][6][2];
        {
            const float* rsp = WSP(float, O_RSS);
            const int lane_ = threadIdx.x & 63, wm_ = (threadIdx.x >> 6) >> 1, fq_ = lane_ >> 4;
#pragma unroll
            for (int mi = 0; mi < 4; ++mi) {
                float rs4[4];
#pragma unroll
                for (int j = 0; j < 4; ++j) rs4[j] = row_rstd(rsp, m0 + wm_ * 64 + mi * 16 + fq_ * 4 + j);
#pragma unroll
                for (int ni = 0; ni < 6; ++ni) {
                    gpk[mi][ni][0] = pk2(sigmoidf_(accg[mi][ni][0] * rs4[0]), sigmoidf_(accg[mi][ni][1] * rs4[1]));
                    gpk[mi][ni][1] = pk2(sigmoidf_(accg[mi][ni][2] * rs4[2]), sigmoidf_(accg[mi][ni][3] * rs4[3]));
                }
            }
        }
        f32x4 accl0[4][2], accl1[4][2], accl2[4][2];
        acc_zero(accl0); acc_zero(accl1); acc_zero(accl2);
        {
            const bf16_t* ocat = WSP(bf16_t, O_OA);
            const bf16_t* lcat = WSP(bf16_t, O_LAT) + (size_t)l * 1024 * 1024;
            gemm_kloop_seg3<4, 2, 8, 4, 4>(smem, [&](int r, int g) { return ocat + (size_t)(m0 + r) * 1024 + g * 64; },
                                           [&](int n, int g) { return lcat + (size_t)(n0 + n) * 1024 + g * 64; }, accl0, accl1, accl2);
        }
        f32x4 accm[4][2];
#pragma unroll
        for (int mi = 0; mi < 4; ++mi)
#pragma unroll
            for (int ni = 0; ni < 2; ++ni) {
                const unsigned a0 = gpk[mi][ni][0], a1 = gpk[mi][ni][1], b0_ = gpk[mi][2 + ni][0], b1_ = gpk[mi][2 + ni][1],
                               c0_ = gpk[mi][4 + ni][0], c1_ = gpk[mi][4 + ni][1];
                accm[mi][ni][0] = bflo(a0) * accl0[mi][ni][0] + bflo(b0_) * accl1[mi][ni][0] + bflo(c0_) * accl2[mi][ni][0];
                accm[mi][ni][1] = bfhi(a0) * accl0[mi][ni][1] + bfhi(b0_) * accl1[mi][ni][1] + bfhi(c0_) * accl2[mi][ni][1];
                accm[mi][ni][2] = bflo(a1) * accl0[mi][ni][2] + bflo(b1_) * accl1[mi][ni][2] + bflo(c1_) * accl2[mi][ni][2];
                accm[mi][ni][3] = bfhi(a1) * accl0[mi][ni][3] + bfhi(b1_) * accl1[mi][ni][3] + bfhi(c1_) * accl2[mi][ni][3];
            }
        gemm_epi<4, 2>(accm, [&](int row, int col, float v) { mg[(size_t)(m0 + row) * 1024 + n0 + col] = (bf16_t)f2bf(v); });
    }
}
DEV void ph_gemm_resid(const Args& a, const bf16_t* A, int K, const bf16_t* Wt, const float* resid_f32, unsigned char* smem) {
    bf16_t* xb = WSP(bf16_t, O_XN);
    float* rsp = WSP(float, O_RSS);
    for (TileIter ti(256, 4); ti.valid(); ti.next()) {
        const int mt = ti.mt(), nt = ti.nt(), m0 = mt * 128, n0 = nt * 256;
        f32x4 acc[4][8];
        acc_zero(acc);
        gemm_kloop32<4, 8>(smem, K, [&](int r, int k0) { return A + (size_t)(m0 + r) * K + k0; },
                           [&](int n, int k0) { return Wt + (size_t)(n0 + n) * K + k0; }, acc);
        const int lane = threadIdx.x & 63, wave = threadIdx.x >> 6, wm = wave >> 1, wn = wave & 1, fr = lane & 15, fq = lane >> 4;
#pragma unroll
        for (int m = 0; m < 4; ++m)
#pragma unroll
            for (int j = 0; j < 4; ++j) {
                const int row = m0 + wm * 64 + m * 16 + fq * 4 + j;
                float ss = 0.f;
#pragma unroll
                for (int n = 0; n < 8; ++n) {
                    const int col = n0 + wn * 128 + n * 16 + fr;
                    const size_t idx = (size_t)row * 1024 + col;
                    const float xo = resid_f32 ? resid_f32[idx] : bflo((unsigned)xb[idx]);
                    const float v = xo + acc[m][n][j];
                    xb[idx] = (bf16_t)f2bf(v);
                    ss += v * v;
                }
                ss = sum16(ss);
                if (fr == 0) rsp[(size_t)(nt * 2 + wn) * T + row] = ss;
            }
    }
}
DEV void ph_gemm_bf16(const Args& a, const bf16_t* A, const bf16_t* Wt, bf16_t* C, int N, unsigned char* smem) {
    const float* rsp = WSP(float, O_RSS);
    const int ntn = N / 256;
    for (TileIter ti(256, ntn); ti.valid(); ti.next()) {
        const int mt = ti.mt(), nt = ti.nt(), m0 = mt * 128, n0 = nt * 256;
        f32x4 acc[4][8];
        acc_zero(acc);
        gemm_kloop32<4, 8>(smem, 1024, [&](int r, int k0) { return A + (size_t)(m0 + r) * 1024 + k0; },
                           [&](int n, int k0) { return Wt + (size_t)(n0 + n) * 1024 + k0; }, acc);
        const int lane = threadIdx.x & 63, wave = threadIdx.x >> 6, wm = wave >> 1, wn = wave & 1, fr = lane & 15, fq = lane >> 4;
#pragma unroll
        for (int m = 0; m < 4; ++m)
#pragma unroll
            for (int j = 0; j < 4; ++j) {
                const int row = m0 + wm * 64 + m * 16 + fq * 4 + j;
                const float rs = row_rstd(rsp, row);
#pragma unroll
                for (int n = 0; n < 8; ++n) C[(size_t)row * N + n0 + wn * 128 + n * 16 + fr] = (bf16_t)f2bf(acc[m][n][j] * rs);
            }
    }
}

DEV void ph_xatt(const Args& a, int l) {
    const int tid = threadIdx.x, wave = tid >> 6, lane = tid & 63, col = lane & 15, q4 = lane >> 4;
    const bf16_t* xaq = WSP(bf16_t, O_XAQ);
    bf16_t* xao = WSP(bf16_t, O_XAO);
    const float* qnw = a.in[I_XQN] + l * 128;
    float M0;
    {
        const float gq = wmaxf(fmaxf(fabsf(qnw[lane]), fabsf(qnw[64 + lane])));
        const float* kn = a.in[I_XKN] + l * 128;
        const float gk = wmaxf(fmaxf(fabsf(kn[lane]), fabsf(kn[64 + lane])));
        M0 = 11.313708499f * gq * gk * LOG2E * 1.01f;
    }
    const int ia = 8 * (col >> 2) + (col & 3);
    const bf16x8 ones = ones_frag();
    for (int it = blockIdx.x; it < 1024; it += gridDim.x) {
        const int bh = it & 7, tt = it >> 3, b = bh >> 2, hd = bh & 3;
        const int t0 = tt * 128 + wave * 32;
        bf16x8 qf[2][4];
#pragma unroll
        for (int ct = 0; ct < 2; ++ct) {
            const size_t tok = (size_t)b * S + t0 + 16 * ct + col;
            float f[4][8];
            float ss = 0.f;
#pragma unroll
            for (int ks = 0; ks < 4; ++ks) {
                const u32x4 rr = *(const u32x4*)(xaq + tok * 512 + hd * 128 + ks * 32 + q4 * 8);
                unpack8(rr, f[ks]);
#pragma unroll
                for (int e = 0; e < 8; ++e) ss += f[ks][e] * f[ks][e];
            }
            ss += __shfl_xor(ss, 16);
            ss += __shfl_xor(ss, 32);
            const float rs = rsqrtf(ss * (1.f / 128.f) + EPS) * (0.08838834764831845f * LOG2E);
#pragma unroll
            for (int ks = 0; ks < 4; ++ks) {
                const float* gw = qnw + ks * 32 + q4 * 8;
                u32x4 w;
                w.x = pk2(f[ks][0] * rs * gw[0], f[ks][1] * rs * gw[1]);
                w.y = pk2(f[ks][2] * rs * gw[2], f[ks][3] * rs * gw[3]);
                w.z = pk2(f[ks][4] * rs * gw[4], f[ks][5] * rs * gw[5]);
                w.w = pk2(f[ks][6] * rs * gw[6], f[ks][7] * rs * gw[7]);
                qf[ct][ks] = __builtin_bit_cast(bf16x8, w);
            }
        }
        const bf16_t* kb_ = WSP(bf16_t, O_XK) + (size_t)((l * 2 + b) * 4 + hd) * 256 * 128;
        const bf16_t* vb_ = WSP(bf16_t, O_XVT) + (size_t)((l * 2 + b) * 4 + hd) * 128 * 256;
        f32x4 o[2][8], lacc[2];
#pragma unroll
        for (int ct = 0; ct < 2; ++ct) {
            lacc[ct] = (f32x4){0.f, 0.f, 0.f, 0.f};
#pragma unroll
            for (int dt = 0; dt < 8; ++dt) o[ct][dt] = (f32x4){0.f, 0.f, 0.f, 0.f};
        }
        for (int G = 0; G < 8; ++G) {
            const int kb0 = 32 * G;
            bf16x8 pf[2];
            {
                bf16x8 ka[4], kb[4];
#pragma unroll
                for (int ks = 0; ks < 4; ++ks) {
                    ka[ks] = ld8(kb_ + (size_t)(kb0 + ia) * 128 + ks * 32 + q4 * 8);
                    kb[ks] = ld8(kb_ + (size_t)(kb0 + ia + 4) * 128 + ks * 32 + q4 * 8);
                }
#pragma unroll
                for (int ct = 0; ct < 2; ++ct) {
                    f32x4 sa = {-M0, -M0, -M0, -M0}, sb = {-M0, -M0, -M0, -M0};
#pragma unroll
                    for (int ks = 0; ks < 4; ++ks) { sa = mfma16(ka[ks], qf[ct][ks], sa); sb = mfma16(kb[ks], qf[ct][ks], sb); }
                    float pa[4], pb[4];
#pragma unroll
                    for (int e = 0; e < 4; ++e) { pa[e] = fexp2(sa[e]); pb[e] = fexp2(sb[e]); }
                    pf[ct] = packp(pa, pb);
                    lacc[ct] = mfma16(ones, pf[ct], lacc[ct]);
                }
            }
#pragma unroll
            for (int dh = 0; dh < 2; ++dh) {
                bf16x8 va[4];
#pragma unroll
                for (int dt = 0; dt < 4; ++dt) va[dt] = ld8(vb_ + (size_t)((dh * 4 + dt) * 16 + col) * 256 + kb0 + q4 * 8);
#pragma unroll
                for (int ct = 0; ct < 2; ++ct)
#pragma unroll
                    for (int dt = 0; dt < 4; ++dt) o[ct][dh * 4 + dt] = mfma16(va[dt], pf[ct], o[ct][dh * 4 + dt]);
            }
        }
#pragma unroll
        for (int ct = 0; ct < 2; ++ct) {
            const size_t tok = (size_t)b * S + t0 + 16 * ct + col;
            const float inv = 1.f / lacc[ct][0];
#pragma unroll
            for (int dt = 0; dt < 8; ++dt) {
                u32x2 w;
                w.x = pk2(o[ct][dt][0] * inv, o[ct][dt][1] * inv);
                w.y = pk2(o[ct][dt][2] * inv, o[ct][dt][3] * inv);
                *(u32x2*)(xao + tok * 512 + hd * 128 + dt * 16 + 4 * q4) = w;
            }
        }
    }
}

DEV void ph_ptop(const Args& a, int l, unsigned char* smem) {
    const bf16_t* pq = WSP(bf16_t, O_PQ);
    const bf16_t* keys = WSP(bf16_t, O_KEYS) + (size_t)l * 2 * 8192;
    unsigned* ptop = WSP(unsigned, O_PTOP);
    float* sc = (float*)smem;
    const int tid = threadIdx.x;
    for (int it = blockIdx.x; it < 512 * 16; it += gridDim.x) {
        const int tt = it >> 4, hh = it & 15, half = hh & 1, t0 = tt * 64;
        f32x4 acc[2][4];
        acc_zero(acc);
        gemm_kloop<2, 4>(smem, 64, [&](int r, int k0) { return pq + (size_t)(t0 + r) * 1024 + hh * 64 + k0; },
                                [&](int n, int k0) { return keys + (size_t)(half * 128 + n) * 64 + k0; }, acc);
        __syncthreads();
        gemm_epi<2, 4>(acc, [&](int row, int col, float v) { sc[row * 132 + col] = v; });
        __syncthreads();
        {
            const int row = tid >> 2, sub = tid & 3;
            unsigned e[32];
#pragma unroll
            for (int i = 0; i < 32; ++i) {
                const int k = 4 * i + sub;
                e[i] = (f2sort(sc[row * 132 + k]) & ~127u) | (unsigned)(127 - k);
            }
            u32x4 mine = {0u, 0u, 0u, 0u};
#pragma unroll
            for (int itk = 0; itk < 16; ++itk) {
                unsigned m = e[0];
#pragma unroll
                for (int i = 1; i < 32; ++i) m = max(m, e[i]);
                m = max4u(m);
#pragma unroll
                for (int i = 0; i < 32; ++i) e[i] = (e[i] == m) ? 0u : e[i];
                if ((itk >> 2) == sub) mine[itk & 3] = m;
            }
            *(u32x4*)(ptop + ((size_t)(t0 + row) * 16 + hh) * 16 + 4 * sub) = mine;
        }
    }
}

DEV void unpack16_fp8(u32x4 r, float* f) {
    const unsigned w[4] = {r.x, r.y, r.z, r.w};
#pragma unroll
    for (int i = 0; i < 4; ++i) {
        const f32x2 lo = __builtin_amdgcn_cvt_pk_f32_fp8((int)w[i], false);
        const f32x2 hi = __builtin_amdgcn_cvt_pk_f32_fp8((int)w[i], true);
        f[4 * i] = lo.x; f[4 * i + 1] = lo.y; f[4 * i + 2] = hi.x; f[4 * i + 3] = hi.y;
    }
}
DEV void ph_pexp(const Args& a, int l, bool dry, unsigned char* smem) {
    const int wave = threadIdx.x >> 6, lane = threadIdx.x & 63;
    const bf16_t* hf = WSP(bf16_t, O_XN);
    const unsigned* ptop = WSP(unsigned, O_PTOP);
    const unsigned char* U = a.ws + O_PU;
    const unsigned char* V = a.ws + O_PVB;
    const float* psc = WSP(float, O_PSC);
    int ci, cj;
    {
        const int L = lane;
        const int i = (L >= 16) + (L >= 24) + (L >= 29) + (L >= 33) + (L >= 36) + (L >= 38) + (L >= 40) + (L >= 42) + (L >= 43) + (L >= 44) +
                      (L >= 45) + (L >= 46) + (L >= 47) + (L >= 48) + (L >= 49);
        const int pre = (i == 0) ? 0 : (i == 1) ? 16 : (i == 2) ? 24 : (i == 3) ? 29 : (i == 4) ? 33 : (i == 5) ? 36 : (i == 6) ? 38 : (i == 7) ? 40 : (34 + i);
        ci = i; cj = L - pre;
    }
    for (int t = blockIdx.x * 4 + wave; t < T; t += gridDim.x * 4) {
        float hv[16];
        {
            const u32x4 r0 = *(const u32x4*)(hf + (size_t)t * 1024 + 16 * lane);
            const u32x4 r1 = *(const u32x4*)(hf + (size_t)t * 1024 + 16 * lane + 8);
            unpack8(r0, hv); unpack8(r1, hv + 8);
            const float rs = row_rstd(WSP(float, O_RSS), t);
#pragma unroll
            for (int i = 0; i < 16; ++i) hv[i] *= rs;
        }
        int* lds_e = (int*)smem + (threadIdx.x >> 6) * 1024;
        float* lds_c = (float*)(lds_e + 512);
#pragma unroll 1
        for (int h = 0; h < 8; ++h) {
            unsigned key = 0u;
            if (lane < 32) key = ptop[((size_t)t * 16 + 2 * h) * 16 + lane];
            const float val = sort2f(key & ~127u);
            const int idx = 127 - (int)(key & 127u);
            const float v1 = __shfl(val, ci), v2 = __shfl(val, 16 + cj);
            unsigned ck = (lane < 50) ? ((f2sort(v1 + v2) & ~255u) | (unsigned)(255 - (ci * 16 + cj))) : 0u;
            int rank = 0;
#pragma unroll
            for (int j = 0; j < 50; ++j) {
                const unsigned cjv = (unsigned)__builtin_amdgcn_readlane((int)ck, j);
                rank += (cjv > ck) ? 1 : 0;
            }
            const int tgt = (lane < 50) ? rank : lane;
            const unsigned mykey = (unsigned)__builtin_amdgcn_ds_permute(tgt * 4, (int)ck);
            const float cv = sort2f(mykey & ~255u);
            const int p = 255 - (int)(mykey & 255u);
            const int ea = __shfl(idx, (p >> 4) & 15), eb = __shfl(idx, 16 + (p & 15));
            const int eid = (ea * 128 + eb) & 16383;
            const float su = psc[eid], sv = psc[16384 + eid];
            const float mx = __shfl(cv, 0);
            float ex = (lane < 16) ? __expf(cv - mx) : 0.f;
            float sm = ex;
            sm = sum16(sm);
            const float gk = ex / sm;
            float d[16];
            {
                u32x4 rr[16];
#pragma unroll
                for (int k = 0; k < 16; ++k) {
                    const int ek = __builtin_amdgcn_readlane(eid, k);
                    rr[k] = *(const u32x4*)(U + (size_t)ek * 1024 + 16 * lane);
                }
#pragma unroll
                for (int k = 0; k < 16; ++k) {
                    float f[16];
                    unpack16_fp8(rr[k], f);
                    float s_ = 0.f;
#pragma unroll
                    for (int i = 0; i < 16; ++i) s_ += f[i] * hv[i];
                    d[k] = s_;
                }
            }
            float d8[8], d4[4], d2[2], d1;
            {
                const bool b5 = (lane & 32) != 0;
#pragma unroll
                for (int i = 0; i < 8; ++i) { const float keep = b5 ? d[i + 8] : d[i], send = b5 ? d[i] : d[i + 8]; d8[i] = keep + __shfl_xor(send, 32); }
                const bool b4 = (lane & 16) != 0;
#pragma unroll
                for (int i = 0; i < 4; ++i) { const float keep = b4 ? d8[i + 4] : d8[i], send = b4 ? d8[i] : d8[i + 4]; d4[i] = keep + __shfl_xor(send, 16); }
                const bool b3 = (lane & 8) != 0;
#pragma unroll
                for (int i = 0; i < 2; ++i) { const float keep = b3 ? d4[i + 2] : d4[i], send = b3 ? d4[i] : d4[i + 2]; d2[i] = keep + __shfl_xor(send, 8); }
                const bool b2 = (lane & 4) != 0;
                { const float keep = b2 ? d2[1] : d2[0], send = b2 ? d2[0] : d2[1]; d1 = keep + __shfl_xor(send, 4); }
                d1 += __shfl_xor(d1, 2);
                d1 += __shfl_xor(d1, 1);
            }
            const float gsh = __shfl(gk, lane >> 2), sush = __shfl(su, lane >> 2), svsh = __shfl(sv, lane >> 2);
            lds_c[h * 64 + lane] = gsh * gelu_t(d1 * sush) * svsh;
            lds_e[h * 64 + lane] = eid;
        }
        lds_fence();
        float outv[16];
#pragma unroll
        for (int i = 0; i < 16; ++i) outv[i] = 0.f;
#pragma unroll 2
        for (int h = 0; h < 8; ++h) {
            const int eh = lds_e[h * 64 + lane];
            const float ch = lds_c[h * 64 + lane];
            u32x4 rr[16];
#pragma unroll
            for (int k = 0; k < 16; ++k) {
                const int ek = __builtin_amdgcn_readlane(eh, k);
                rr[k] = *(const u32x4*)(V + (size_t)ek * 1024 + 16 * lane);
            }
#pragma unroll
            for (int k = 0; k < 16; ++k) {
                const float ck2 = __builtin_bit_cast(float, __builtin_amdgcn_readlane(__builtin_bit_cast(int, ch), 4 * k));
                float f[16];
                unpack16_fp8(rr[k], f);
#pragma unroll
                for (int i = 0; i < 16; ++i) outv[i] += ck2 * f[i];
            }
        }
        float xraw[16];
        {
            const u32x4 r0 = *(const u32x4*)(hf + (size_t)t * 1024 + 16 * lane);
            const u32x4 r1 = *(const u32x4*)(hf + (size_t)t * 1024 + 16 * lane + 8);
            unpack8(r0, xraw); unpack8(r1, xraw + 8);
        }
        float4 x0, x1, x2, x3;
        x0.x = xraw[0] + outv[0]; x0.y = xraw[1] + outv[1]; x0.z = xraw[2] + outv[2]; x0.w = xraw[3] + outv[3];
        x1.x = xraw[4] + outv[4]; x1.y = xraw[5] + outv[5]; x1.z = xraw[6] + outv[6]; x1.w = xraw[7] + outv[7];
        x2.x = xraw[8] + outv[8]; x2.y = xraw[9] + outv[9]; x2.z = xraw[10] + outv[10]; x2.w = xraw[11] + outv[11];
        x3.x = xraw[12] + outv[12]; x3.y = xraw[13] + outv[13]; x3.z = xraw[14] + outv[14]; x3.w = xraw[15] + outv[15];
        if (!dry) {
            if (l + 1 < NL) {
                float ss = x0.x * x0.x + x0.y * x0.y + x0.z * x0.z + x0.w * x0.w + x1.x * x1.x + x1.y * x1.y + x1.z * x1.z + x1.w * x1.w +
                           x2.x * x2.x + x2.y * x2.y + x2.z * x2.z + x2.w * x2.w + x3.x * x3.x + x3.y * x3.y + x3.z * x3.z + x3.w * x3.w;
                ss = wsum(ss);
                u32x4 w0, w1;
                w0.x = pk2(x0.x, x0.y); w0.y = pk2(x0.z, x0.w); w0.z = pk2(x1.x, x1.y); w0.w = pk2(x1.z, x1.w);
                w1.x = pk2(x2.x, x2.y); w1.y = pk2(x2.z, x2.w); w1.z = pk2(x3.x, x3.y); w1.w = pk2(x3.z, x3.w);
                bf16_t* xr = WSP(bf16_t, O_XN) + (size_t)t * 1024 + 16 * lane;
                *(u32x4*)xr = w0;
                *(u32x4*)(xr + 8) = w1;
                if (lane < 8) WSP(float, O_RSS)[(size_t)lane * T + t] = ss * 0.125f;
            } else {
                float4* orow = (float4*)(a.out + (size_t)t * 1024 + 16 * lane);
                orow[0] = x0; orow[1] = x1; orow[2] = x2; orow[3] = x3;
            }
        }
    }
}

#ifndef REP_ID
#define REP_ID -1
#endif
#define REPX(id, dryvar, call) { const int nrp_ = (REP_ID == (id) && l == 0) ? 2 : 1; for (int rp_ = 0; rp_ < nrp_; ++rp_) { const bool dryvar = (nrp_ == 2 && rp_ == 0); (void)dryvar; call; } }
#define STEP_BEGIN { ArgsP ap_ = ap; asm volatile("" : "+s"(ap_)); const Args a = *ap_; if (step >= a.ph_lo && step < a.ph_hi) {
#define STEP_END } ++step; if (step > a.ph_lo && step < a.ph_hi) { if (a.ph_lo < 0) cg::this_grid().sync();   else xcd_barrier((unsigned*)a.ws, xb_xcc_id(), (volatile LAS unsigned*)(LAS unsigned char*)smem + 16384); } }
#if defined(__HIP_DEVICE_COMPILE__)
typedef const __attribute__((address_space(4))) Args* ArgsP;
template <int l>
DEV void layer_steps(ArgsP ap, unsigned char* smem, int& step) {
    STEP_BEGIN
        REPX(1, dry, ph_gemm1(a, l, smem));
        REPX(2, dry, ph_peercvt(a, l));
    STEP_END
    STEP_BEGIN
        REPX(4, dry, ph_cmp1(a, l, smem));
        if (l == 0) ph_mem2(a, smem, 256);
        REPX(3, dry, ph_post(a, l, smem));
    STEP_END
    STEP_BEGIN
        if (l == 0) ph_mem3(a);
        REPX(5, dry, ph_cmp2(a, l));
        REPX(7, dry, ph_sgu(a, l, smem));
        REPX(8, dry, ph_pool(a, l, smem));
    STEP_END
    STEP_BEGIN
        REPX(6, dry, ph_nsa(a, l, smem));
    STEP_END
    STEP_BEGIN
        REPX(9, dry, ph_merge(a, l, smem));
    STEP_END
    STEP_BEGIN
        ph_gemm_resid(a, WSP(bf16_t, O_MERGED), 1024, WSP(bf16_t, O_WOT) + (size_t)l * 1024 * 1024, (const float*)nullptr, smem);
    STEP_END
    STEP_BEGIN
        REPX(12, dry, ph_gemm_bf16(a, WSP(bf16_t, O_XN), WSP(bf16_t, O_XWQT) + (size_t)l * 512 * 1024, WSP(bf16_t, O_XAQ), 512, smem));
    STEP_END
    STEP_BEGIN
        REPX(13, dry, ph_xatt(a, l));
    STEP_END
    STEP_BEGIN
        ph_gemm_resid(a, WSP(bf16_t, O_XAO), 512, WSP(bf16_t, O_XWOT) + (size_t)l * 1024 * 512, (const float*)nullptr, smem);
    STEP_END
    STEP_BEGIN
        REPX(14, dry, ph_gemm_bf16(a, WSP(bf16_t, O_XN), WSP(bf16_t, O_PWQT) + (size_t)l * 1024 * 1024, WSP(bf16_t, O_PQ), 1024, smem));
    STEP_END
    STEP_BEGIN
        REPX(15, dry, ph_ptop(a, l, smem));
    STEP_END
    STEP_BEGIN
        REPX(16, dry, ph_pexp(a, l, dry, smem));
    STEP_END
}
#endif
__global__ void __launch_bounds__(256, 2) fwd_kernel(Args a_by_value) {
#if defined(__HIP_DEVICE_COMPILE__)
    ArgsP ap = (ArgsP)__builtin_amdgcn_kernarg_segment_ptr();
    extern __shared__ __attribute__((aligned(16))) unsigned char smem[];
    if (threadIdx.x < 4) ((volatile LAS unsigned*)(LAS unsigned char*)smem)[16384 + threadIdx.x] = 0u;
    __syncthreads();
    if (ap->ph_hi - ap->ph_lo > 1) (void)xcd_barrier_post((unsigned*)ap->ws, (volatile LAS unsigned*)(LAS unsigned char*)smem + 16384);
    int step = 0;
    STEP_BEGIN
        ph_prep(a, smem);
        ph_mem1(a);
        x_to_bf16_rss(a.in[I_X], WSP(bf16_t, O_XN), WSP(float, O_RSS), T);
    STEP_END
    layer_steps<0>(ap, smem, step);
    layer_steps<1>(ap, smem, step);
#endif
}
constexpr int N_STEPS = 1 + 12 + 12;
constexpr int LDS_DYN = 65536 + 64;

extern "C" void kernel_launch(void* const* d_in, const int* in_sizes, int n_in, void* d_out, int out_size, void* d_ws, size_t ws_size,
                              hipStream_t stream) {
    static int grid_blocks = 0;
    if (!grid_blocks) {
        int dev = 0, cus = 0, per_cu = 0;
        hipGetDevice(&dev);
        hipDeviceGetAttribute(&cus, hipDeviceAttributeMultiprocessorCount, dev);
        hipFuncSetAttribute((const void*)fwd_kernel, hipFuncAttributeMaxDynamicSharedMemorySize, LDS_DYN);
        hipOccupancyMaxActiveBlocksPerMultiprocessor(&per_cu, fwd_kernel, 256, LDS_DYN);
        if (per_cu > 2) per_cu = 2;
        if (per_cu < 1) per_cu = 1;
        grid_blocks = cus * per_cu;
    }
    if (ws_size < WS_NEED) { fprintf(stderr, "workspace too small: %zu < %zu\n", ws_size, (size_t)WS_NEED); return; }
    Args a{};
    for (int i = 0; i < N_IN; ++i) a.in[i] = (const float*)d_in[i];
    a.out = (float*)d_out;
    a.ws = (unsigned char*)d_ws;
#if MEGA
    a.ph_lo = 0; a.ph_hi = N_STEPS;
    void* args[] = {&a};
    (void)hipMemsetAsync(d_ws, 0, 16384, stream);
    hipError_t e = hipLaunchCooperativeKernel((void*)fwd_kernel, dim3(grid_blocks), dim3(256), args, LDS_DYN, stream);
    if (e != hipSuccess) fprintf(stderr, "cooperative launch failed: %s (grid %d)\n", hipGetErrorString(e), grid_blocks);
#else
    for (int s = 0; s < N_STEPS; ++s) {
        a.ph_lo = s; a.ph_hi = s + 1;
        fwd_kernel<<<dim3(grid_blocks), dim3(256), LDS_DYN, stream>>>(a);
    }
#endif
}
```
